# Optimizing an MI355X kernel written in HIP

```python
import math
import jax, jax.numpy as jnp
from jax import lax
import numpy as np

D_MODEL = 1024
BATCH = 8
SEQ = 4096
DEPTH = 4

CHUNK = 64
N_META = 16
Q_BLOCK = 128
HEAD_DIM = 64
SB_HEADS = 8
MLA_HEADS = 8
MLA_NOPE = 64
MLA_ROPE = 32
MLA_V = 64
MLA_Q_RANK = 256
MLA_KV_RANK = 256
ROPE_BASE = 10000.0
SWA_HEADS = 8
SWA_KV_HEADS = 2
WINDOW = 128
WINDOW_CHUNKS = WINDOW // CHUNK
BAND_BACK = WINDOW + CHUNK
FOX_HEADS = 8
FORGET_BIAS_INIT = 3.0

A_WIDTH = SB_HEADS * HEAD_DIM
B_WIDTH = MLA_HEADS * MLA_V
C_WIDTH = SWA_HEADS * HEAD_DIM
C_KV_WIDTH = SWA_KV_HEADS * HEAD_DIM
D_WIDTH = FOX_HEADS * HEAD_DIM
EVEN_WIDTH = A_WIDTH + B_WIDTH
ODD_WIDTH = C_WIDTH + D_WIDTH
EVEN_IN = 3 * A_WIDTH + MLA_Q_RANK + MLA_KV_RANK + MLA_ROPE + EVEN_WIDTH
ODD_IN = C_WIDTH + 2 * C_KV_WIDTH + 3 * D_WIDTH + FOX_HEADS + ODD_WIDTH
N_EVEN = (DEPTH + 1) // 2
N_ODD = DEPTH // 2

DN_ALPHA = (2 * DEPTH) ** 0.25
DN_BETA = (8 * DEPTH) ** -0.25
LN_EPS = 1e-5
RMS_EPS = 1e-6
NEG = -1e30

kernel_name = 'hybrid_chunk_causal_sb_mla_swa_fox'


def _split(t, sizes):
    out, start = [], 0
    for w in sizes:
        out.append(t[..., start:start + w])
        start += w
    return out


def _layer_norm(x, g, b):
    xf = x.astype(jnp.float32)
    mu = jnp.mean(xf, -1, keepdims=True)
    var = jnp.mean(jnp.square(xf - mu), -1, keepdims=True)
    return ((xf - mu) * lax.rsqrt(var + LN_EPS) * g.astype(jnp.float32) + b.astype(jnp.float32)).astype(x.dtype)


def _rms_norm(x, g):
    xf = x.astype(jnp.float32)
    return (xf * lax.rsqrt(jnp.mean(xf * xf, -1, keepdims=True) + RMS_EPS) * g.astype(jnp.float32)).astype(x.dtype)


def _rope(x, pos):
    half = x.shape[-1] // 2
    inv = ROPE_BASE ** (-jnp.arange(half, dtype=jnp.float32) / half)
    ang = pos.astype(jnp.float32)[:, None] * inv[None, :]
    cos = jnp.cos(ang)[None, :, None, :]
    sin = jnp.sin(ang)[None, :, None, :]
    xf = x.astype(jnp.float32)
    x1, x2 = xf[..., :half], xf[..., half:]
    return jnp.concatenate([x1 * cos - x2 * sin, x2 * cos + x1 * sin], -1).astype(x.dtype)


def _chunk_index(pos):
    return jnp.where(pos < N_META, 0, 1 + (pos - N_META) // CHUNK)


def _alibi_slopes(n):
    return jnp.asarray([2.0 ** (-8.0 * (h + 1) / n) for h in range(n)], dtype=jnp.float32)


def _stick_breaking(q, k, v):
    n = q.shape[1]
    scale = HEAD_DIM ** -0.5
    outs = []
    for q0 in range(0, n, Q_BLOCK):
        q1 = q0 + Q_BLOCK
        z = jnp.einsum('bqhd,bkhd->bhqk', q[:, q0:q1], k[:, :q1]).astype(jnp.float32) * scale
        past = jnp.arange(q1)[None, :] < jnp.arange(q0, q1)[:, None]
        log_stay = jnp.where(past, jax.nn.log_sigmoid(-z), 0.0)
        log_after = lax.cumsum(log_stay, axis=3, reverse=True) - log_stay
        w = jnp.where(past, jnp.exp(jax.nn.log_sigmoid(z) + log_after), 0.0)
        outs.append(jnp.einsum('bhqk,bkhd->bqhd', w.astype(v.dtype), v[:, :q1]))
    return jnp.concatenate(outs, axis=1)


def _mla(q_nope, q_rope, k_nope, k_rope, v, chunk):
    n = q_nope.shape[1]
    scale = (MLA_NOPE + MLA_ROPE) ** -0.5
    outs = []
    for q0 in range(0, n, Q_BLOCK):
        q1 = q0 + Q_BLOCK
        k1 = min(n, q1 + CHUNK)
        s = (jnp.einsum('bqhd,bkhd->bhqk', q_nope[:, q0:q1], k_nope[:, :k1])
             + jnp.einsum('bqhr,bkr->bhqk', q_rope[:, q0:q1], k_rope[:, :k1])).astype(jnp.float32) * scale
        vis = chunk[None, :k1] <= chunk[q0:q1, None]
        p = jax.nn.softmax(jnp.where(vis, s, NEG), axis=-1)
        outs.append(jnp.einsum('bhqk,bkhd->bqhd', p.astype(v.dtype), v[:, :k1]))
    return jnp.concatenate(outs, axis=1)


def _swa_sinks(q, k, v, sinks, chunk):
    b, n, hq, d = q.shape
    group = SWA_HEADS // SWA_KV_HEADS
    qg = q.reshape(b, n, SWA_KV_HEADS, group, d)
    slopes = _alibi_slopes(SWA_HEADS).reshape(SWA_KV_HEADS, group)
    sink = sinks.astype(jnp.float32).reshape(SWA_KV_HEADS, group)
    scale = HEAD_DIM ** -0.5
    outs = []
    for q0 in range(0, n, Q_BLOCK):
        q1 = q0 + Q_BLOCK
        k0 = max(N_META, q0 - BAND_BACK)
        k1 = min(n, q1 + CHUNK)
        kidx = jnp.concatenate([jnp.arange(N_META), jnp.arange(k0, k1)])
        kk = jnp.concatenate([k[:, :N_META], k[:, k0:k1]], axis=1)
        vv = jnp.concatenate([v[:, :N_META], v[:, k0:k1]], axis=1)
        tq = jnp.arange(q0, q1)
        dist = jnp.abs(tq[:, None] - kidx[None, :]).astype(jnp.float32)
        s = (jnp.einsum('bqgnd,bkgd->bgnqk', qg[:, q0:q1], kk).astype(jnp.float32) * scale
             - slopes[:, :, None, None] * dist)
        ct = chunk[q0:q1][:, None]
        cs = chunk[kidx][None, :]
        vis = (cs <= ct) & ((ct - cs <= WINDOW_CHUNKS) | (kidx[None, :] < N_META))
        s = jnp.where(vis, s, NEG)
        sink_col = jnp.broadcast_to(sink[None, :, :, None, None], s.shape[:-1] + (1,))
        p = jax.nn.softmax(jnp.concatenate([s, sink_col], axis=-1), axis=-1)[..., :-1]
        o = jnp.einsum('bgnqk,bkgd->bqgnd', p.astype(v.dtype), vv)
        outs.append(o.reshape(b, q1 - q0, hq, d))
    return jnp.concatenate(outs, axis=1)


def _forgetting(q, k, v, log_f):
    n = q.shape[1]
    scale = HEAD_DIM ** -0.5
    cum = jnp.cumsum(log_f, axis=1).transpose(0, 2, 1)
    outs = []
    for q0 in range(0, n, Q_BLOCK):
        q1 = q0 + Q_BLOCK
        s = (jnp.einsum('bqhd,bkhd->bhqk', q[:, q0:q1], k[:, :q1]).astype(jnp.float32) * scale
             + cum[:, :, q0:q1, None] - cum[:, :, None, :q1])
        vis = jnp.arange(q1)[None, :] <= jnp.arange(q0, q1)[:, None]
        p = jax.nn.softmax(jnp.where(vis, s, NEG), axis=-1)
        outs.append(jnp.einsum('bhqk,bkhd->bqhd', p.astype(v.dtype), v[:, :q1]))
    return jnp.concatenate(outs, axis=1)


def _even_mixer(h, w_in, g_cq, g_ckv, w_uq, w_ukv, w_out, chunk):
    b, n, _ = h.shape
    proj = h @ w_in
    qa, ka, va, cq, ckv, kr, gate = _split(
        proj, [A_WIDTH, A_WIDTH, A_WIDTH, MLA_Q_RANK, MLA_KV_RANK, MLA_ROPE, EVEN_WIDTH])
    heads = lambda t, nh: t.reshape(b, n, nh, -1)
    o_a = _stick_breaking(heads(qa, SB_HEADS), heads(ka, SB_HEADS), heads(va, SB_HEADS))
    pos = jnp.arange(n)
    q = (_rms_norm(cq, g_cq) @ w_uq).reshape(b, n, MLA_HEADS, MLA_NOPE + MLA_ROPE)
    kv = (_rms_norm(ckv, g_ckv) @ w_ukv).reshape(b, n, MLA_HEADS, MLA_NOPE + MLA_V)
    q_rope = _rope(q[..., MLA_NOPE:], pos)
    k_rope = _rope(kr[:, :, None, :], pos)[:, :, 0]
    o_b = _mla(q[..., :MLA_NOPE], q_rope, kv[..., :MLA_NOPE], k_rope, kv[..., MLA_NOPE:], chunk)
    mixed = jnp.concatenate([o_a.reshape(b, n, A_WIDTH), o_b.reshape(b, n, B_WIDTH)], axis=-1)
    return (mixed * jax.nn.silu(gate)) @ w_out


def _odd_mixer(h, w_in, b_forget, sinks, w_out, chunk):
    b, n, _ = h.shape
    proj = h @ w_in
    qc, kc, vc, qd, kd, vd, fz, gate = _split(
        proj, [C_WIDTH, C_KV_WIDTH, C_KV_WIDTH, D_WIDTH, D_WIDTH, D_WIDTH, FOX_HEADS, ODD_WIDTH])
    heads = lambda t, nh: t.reshape(b, n, nh, -1)
    o_c = _swa_sinks(heads(qc, SWA_HEADS), heads(kc, SWA_KV_HEADS), heads(vc, SWA_KV_HEADS), sinks, chunk)
    log_f = jax.nn.log_sigmoid(fz.astype(jnp.float32) + b_forget.astype(jnp.float32))
    o_d = _forgetting(heads(qd, FOX_HEADS), heads(kd, FOX_HEADS), heads(vd, FOX_HEADS), log_f)
    mixed = jnp.concatenate([o_c.reshape(b, n, C_WIDTH), o_d.reshape(b, n, D_WIDTH)], axis=-1)
    return (mixed * jax.nn.silu(gate)) @ w_out


def setup_inputs(seed: int = 0) -> dict:
    key = jax.random.key(seed)
    ks = jax.random.split(key, 15)
    nrm = lambda k, shape, scale: jax.random.normal(k, shape, jnp.float32) * scale
    return {
        'x': nrm(ks[0], (BATCH, SEQ, D_MODEL), 1.0),
        'meta_tokens': nrm(ks[1], (N_META, D_MODEL), 1.0),
        'w_in_even': nrm(ks[2], (N_EVEN, D_MODEL, EVEN_IN), D_MODEL ** -0.5),
        'g_cq': 1.0 + nrm(ks[3], (N_EVEN, MLA_Q_RANK), 0.02),
        'g_ckv': 1.0 + nrm(ks[4], (N_EVEN, MLA_KV_RANK), 0.02),
        'w_uq': nrm(ks[5], (N_EVEN, MLA_Q_RANK, MLA_HEADS * (MLA_NOPE + MLA_ROPE)), MLA_Q_RANK ** -0.5),
        'w_ukv': nrm(ks[6], (N_EVEN, MLA_KV_RANK, MLA_HEADS * (MLA_NOPE + MLA_V)), MLA_KV_RANK ** -0.5),
        'w_out_even': nrm(ks[7], (N_EVEN, EVEN_WIDTH, D_MODEL), DN_BETA * EVEN_WIDTH ** -0.5),
        'w_in_odd': nrm(ks[8], (N_ODD, D_MODEL, ODD_IN), D_MODEL ** -0.5),
        'b_forget': FORGET_BIAS_INIT + nrm(ks[9], (N_ODD, FOX_HEADS), 0.1),
        'sink_logits': nrm(ks[10], (N_ODD, SWA_HEADS), 0.5),
        'w_out_odd': nrm(ks[11], (N_ODD, ODD_WIDTH, D_MODEL), DN_BETA * ODD_WIDTH ** -0.5),
        'ln_gain': 1.0 + nrm(ks[12], (DEPTH, D_MODEL), 0.02),
        'ln_bias': nrm(ks[13], (DEPTH, D_MODEL), 0.02),
    }


def reference(x, meta_tokens, w_in_even, g_cq, g_ckv, w_uq, w_ukv, w_out_even,
              w_in_odd, b_forget, sink_logits, w_out_odd, ln_gain, ln_bias):
    b, s, d = x.shape
    n = s + N_META
    n_pad = -(-n // Q_BLOCK) * Q_BLOCK
    h = jnp.concatenate([jnp.broadcast_to(meta_tokens[None].astype(x.dtype), (b, N_META, d)), x,
                         jnp.zeros((b, n_pad - n, d), x.dtype)], axis=1)
    chunk = _chunk_index(jnp.arange(n_pad))
    for layer in range(DEPTH):
        i = layer // 2
        if layer % 2 == 0:
            y = _even_mixer(h, w_in_even[i], g_cq[i], g_ckv[i], w_uq[i], w_ukv[i], w_out_even[i], chunk)
        else:
            y = _odd_mixer(h, w_in_odd[i], b_forget[i], sink_logits[i], w_out_odd[i], chunk)
        h = _layer_norm(DN_ALPHA * h + y, ln_gain[layer], ln_bias[layer])
    return h[:, N_META:N_META + s]
```

```cpp
#include <hip/hip_runtime.h>
#include <hip/hip_cooperative_groups.h>
#include <cstdio>
#include <cstdint>
namespace cg = cooperative_groups;

#define LAS __attribute__((address_space(3)))
typedef unsigned short bf16_t;
typedef short bf16x8 __attribute__((ext_vector_type(8)));
typedef short s16x4 __attribute__((ext_vector_type(4)));
typedef float f32x4 __attribute__((ext_vector_type(4)));
typedef float f32x16 __attribute__((ext_vector_type(16)));
typedef unsigned u32x2 __attribute__((ext_vector_type(2)));
typedef unsigned u32x4 __attribute__((ext_vector_type(4)));

constexpr int DM = 1024, NB = 8, SEQ = 4096, NMETA = 16;
constexpr int POFF = 48;
constexpr int LPAD = 4160;
constexpr int T = NB * LPAD;
constexpr int NMT = T / 256;
constexpr int NIN = 3328;
constexpr int SRC_EVEN_IN = 3104, SRC_ODD_IN = 3336;
constexpr int NUNIT_SEQ = LPAD / 32;
constexpr float LOG2E = 1.4426950408889634f;
constexpr float DN_ALPHA = 1.681792830507429f;
constexpr float NEGB = -1e30f;

constexpr int E_GATE = 2048, E_KR = 3072, O_GATE = 2304;

constexpr size_t SZ_H = (size_t)T * DM * 4, SZ_HB = (size_t)T * DM * 2, SZ_PROJ = (size_t)T * NIN * 2, SZ_QM = (size_t)T * 768 * 2;
constexpr size_t OFF_H = 0, OFF_HB = OFF_H + SZ_H, OFF_PROJ = OFF_HB + SZ_HB, OFF_QM = OFF_PROJ + SZ_PROJ, OFF_W = OFF_QM + SZ_QM;
constexpr size_t SZ_WIN = (size_t)NIN * DM * 2, SZ_WUQ = 768 * 256 * 2, SZ_WUKV = 1024 * 256 * 2, SZ_WOUT = (size_t)DM * DM * 2;
constexpr size_t OFF_WINE = OFF_W, OFF_WUQ = OFF_WINE + 2 * SZ_WIN, OFF_WUKV = OFF_WUQ + 2 * SZ_WUQ, OFF_WOUTE = OFF_WUKV + 2 * SZ_WUKV,
                 OFF_WINO = OFF_WOUTE + 2 * SZ_WOUT, OFF_WOUTO = OFF_WINO + 2 * SZ_WIN, OFF_SSQ = OFF_WOUTO + 2 * SZ_WOUT;
constexpr size_t SZ_SSQ = (size_t)4 * T * 4;
constexpr size_t OFF_LCUM = OFF_SSQ + SZ_SSQ, SZ_LCUM = (size_t)NB * 8 * LPAD * 4;
constexpr size_t OFF_UTOT = OFF_LCUM + SZ_LCUM, SZ_UTOT = (size_t)NB * 8 * 256 * 4;
constexpr size_t OFF_ROPE = OFF_UTOT + SZ_UTOT, SZ_ROPE = (size_t)LPAD * 16 * 8;
constexpr size_t WS_END = OFF_ROPE + SZ_ROPE;

struct Params {
    const float *x, *meta, *w_in_even, *g_cq, *g_ckv, *w_uq, *w_ukv, *w_out_even, *w_in_odd, *b_forget, *sinks, *w_out_odd, *ln_gain, *ln_bias;
    float* out; unsigned char* ws;
};

__device__ __forceinline__ unsigned cvtpk(float lo, float hi) { unsigned r; asm volatile("v_cvt_pk_bf16_f32 %0, %1, %2" : "=v"(r) : "v"(lo), "v"(hi)); return r; }
__device__ __forceinline__ float shx(float v, int mask, int lane) { return __int_as_float(__builtin_amdgcn_ds_bpermute((lane ^ mask) << 2, __float_as_int(v))); }
__device__ __forceinline__ int crow(int r, int hi) { return (r & 3) + 8 * (r >> 2) + 4 * hi; }
__device__ __forceinline__ float silu_f(float x) { return x / (1.f + __expf(-x)); }
__device__ __forceinline__ void store4bf(bf16_t* p, f32x4 v) { u32x2 w; w.x = cvtpk(v[0], v[1]); w.y = cvtpk(v[2], v[3]); *(u32x2*)p = w; }

constexpr int HTB = 128 * 64 * 2;
__device__ __forceinline__ int lds_byte(int r, int c) { const int st = (r >> 4) * 2 + (c >> 5), rr = r & 15, cc = c & 31, ob = rr * 64 + cc * 2; return st * 1024 + (ob ^ (((ob >> 9) & 1) << 5)); }
__device__ __forceinline__ void stage_rc(int b, int& R, int& C) { const int st = b / 1024, sb = b % 1024, swz = sb ^ (((sb >> 9) & 1) << 5); R = (st >> 1) * 16 + swz / 64; C = (st & 1) * 32 + (swz % 64) / 2; }

enum { TR_NONE = 0, TR_SCALE, TR_SILU, TR_SSQ, TR_ROPEKR, TR_UPQ, TR_UPKV, TR_OUT };
struct Epi { int tr; float fac; bf16_t* dst; int ldd; float* aux; const float2* rope; };

struct TileOrder {
    int nM, nN, nwg;
    __device__ __forceinline__ void init(int nM_, int nN_) { nM = nM_; nN = nN_; nwg = nM * nN; }
    __device__ __forceinline__ bool get(int L, int& pm, int& pn) const {
        if (L >= nwg) return false;
        int wgid = L; { const int q = nwg / 8, r = nwg % 8, xcd = wgid % 8, off = wgid / 8; wgid = (xcd < r ? xcd * (q + 1) : r * (q + 1) + (xcd - r) * q) + off; }
        const int nig = 8 * nN, gid = wgid / nig, fm = gid * 8, gsz = (nM - fm) < 8 ? (nM - fm) : 8;
        pm = fm + ((wgid % nig) % gsz); pn = (wgid % nig) / gsz; return true;
    }
};

#define G_SA(b, h) (((b) * 2 + (h)) * HTB)
#define G_SB(b, h) ((4 + (b) * 2 + (h)) * HTB)
#define G_STAGE(bufoff, gbase, voff, qstep) do { _Pragma("unroll") for (int _i = 0; _i < 2; ++_i) \
    __builtin_amdgcn_global_load_lds((const unsigned*)((const char*)(gbase) + (size_t)_i * (qstep) + (voff)), (LAS unsigned*)(lds + (bufoff) + ldsw + _i * 8192), 16, 0, 0); } while (0)
#define G_STA(b, h, kt) G_STAGE(G_SA(b, h), Ab + (size_t)(h) * hstepA + (size_t)(kt) * 128, voffA, qstepA)
#define G_STB(b, h, kt) G_STAGE(G_SB(b, h), Bb + (size_t)(h) * hstepB + (size_t)(kt) * 128, voffB, qstepB)
#define G_LDA(dst, b, h) do { _Pragma("unroll") for (int m = 0; m < 4; ++m) _Pragma("unroll") for (int k = 0; k < 2; ++k) dst[m][k] = *(const LAS bf16x8*)(lds + G_SA(b, h) + aoff + m * 2048 + k * 1024); } while (0)
#define G_LDB(dst, b, h) do { _Pragma("unroll") for (int n = 0; n < 2; ++n) _Pragma("unroll") for (int k = 0; k < 2; ++k) dst[n][k] = *(const LAS bf16x8*)(lds + G_SB(b, h) + boff + n * 2048 + k * 1024); } while (0)
#define G_MMA(ai, bj, At, Bt) do { __builtin_amdgcn_s_setprio(1); _Pragma("unroll") for (int m = 0; m < 4; ++m) _Pragma("unroll") for (int n = 0; n < 2; ++n) _Pragma("unroll") for (int k = 0; k < 2; ++k) \
    acc[ai][bj][m][n] = __builtin_amdgcn_mfma_f32_16x16x32_bf16(Bt[n][k], At[m][k], acc[ai][bj][m][n], 0, 0, 0); __builtin_amdgcn_s_setprio(0); } while (0)
#define WAIT_V(n) asm volatile("s_waitcnt vmcnt(" #n ")" ::: "memory")
#define WAIT_L(n) asm volatile("s_waitcnt lgkmcnt(" #n ")" ::: "memory")
#define BAR __builtin_amdgcn_s_barrier()
#define SCHED __builtin_amdgcn_sched_barrier(0)

enum { GK_IN_EVEN = 0, GK_IN_ODD, GK_UPQ, GK_UPKV, GK_OUT_EVEN, GK_OUT_ODD };
__device__ __forceinline__ void gemm_unit(LAS unsigned char* lds, unsigned char* ws, int kind_, int li_, int pm_, int pn_) {
    asm volatile("" : "+s"(ws));
    const int kind = __builtin_amdgcn_readfirstlane(kind_), li = __builtin_amdgcn_readfirstlane(li_), pm = __builtin_amdgcn_readfirstlane(pm_), pn = __builtin_amdgcn_readfirstlane(pn_);
    int tid = threadIdx.x; asm volatile("" : "+v"(tid));
    const int wid = __builtin_amdgcn_readfirstlane(tid >> 6), lane = tid & 63, wr = wid >> 2, wc = wid & 3, fr = lane & 15, fq = lane >> 4;
    const bf16_t* A; const bf16_t* Bt; int lda, ldb, K;
    {
        const bf16_t* proj = (const bf16_t*)(ws + OFF_PROJ);
        if (kind == GK_IN_EVEN)       { A = (const bf16_t*)(ws + OFF_HB); lda = DM; Bt = (const bf16_t*)(ws + OFF_WINE + li * SZ_WIN); ldb = DM; K = DM; }
        else if (kind == GK_IN_ODD)   { A = (const bf16_t*)(ws + OFF_HB); lda = DM; Bt = (const bf16_t*)(ws + OFF_WINO + li * SZ_WIN); ldb = DM; K = DM; }
        else if (kind == GK_UPQ)      { A = proj + 1536; lda = NIN; Bt = (const bf16_t*)(ws + OFF_WUQ + li * SZ_WUQ); ldb = 256; K = 256; }
        else if (kind == GK_UPKV)     { A = proj + 1792; lda = NIN; Bt = (const bf16_t*)(ws + OFF_WUKV + li * SZ_WUKV); ldb = 256; K = 256; }
        else if (kind == GK_OUT_EVEN) { A = proj + E_GATE; lda = NIN; Bt = (const bf16_t*)(ws + OFF_WOUTE + li * SZ_WOUT); ldb = DM; K = DM; }
        else                          { A = proj + O_GATE; lda = NIN; Bt = (const bf16_t*)(ws + OFF_WOUTO + li * SZ_WOUT); ldb = DM; K = DM; }
    }
    unsigned voffA, voffB;
    { int R, C; stage_rc(tid * 16, R, C); voffA = (unsigned)((R * lda + C) * 2); voffB = (unsigned)((R * ldb + C) * 2); }
    const size_t qstepA = (size_t)64 * lda * 2, qstepB = (size_t)64 * ldb * 2;
    const char* Ab = (const char*)(A + (size_t)pm * 256 * lda);
    const char* Bb = (const char*)(Bt + (size_t)pn * 256 * ldb);
    const size_t hstepA = (size_t)128 * lda * 2, hstepB = (size_t)128 * ldb * 2;
    const unsigned ldsw = (unsigned)wid * 1024u;
    const int aoff = lds_byte(wr * 64 + fr, fq * 8), boff = lds_byte(wc * 32 + fr, fq * 8);
    f32x4 acc[2][2][4][2];
#pragma unroll
    for (int a = 0; a < 2; ++a)
#pragma unroll
        for (int b = 0; b < 2; ++b)
#pragma unroll
            for (int m = 0; m < 4; ++m)
#pragma unroll
                for (int n = 0; n < 2; ++n) acc[a][b][m][n] = (f32x4){0.f, 0.f, 0.f, 0.f};
    bf16x8 At[4][2], B0[2][2], B1[2][2];
    const int nt = K / 64;
    WAIT_V(0);
    G_STB(0, 0, 0); G_STA(0, 0, 0); G_STB(0, 1, 0); G_STA(0, 1, 0);
    if (wr == 1) BAR;
    WAIT_V(4); BAR;
    G_STB(1, 0, 1); G_STA(1, 0, 1); G_STB(1, 1, 1);
    WAIT_V(6); BAR;
    for (int t = 0; t < nt - 2; t += 2) {
        G_LDB(B0, 0, 0); SCHED; G_LDA(At, 0, 0); G_STA(1, 1, t + 1);
        WAIT_L(8); BAR; WAIT_L(0); G_MMA(0, 0, At, B0); BAR; SCHED;
        G_LDB(B1, 0, 1); G_STB(0, 0, t + 2);
        BAR; WAIT_L(0); G_MMA(0, 1, At, B1); BAR;
        G_LDA(At, 0, 1); G_STA(0, 0, t + 2);
        BAR; WAIT_L(0); G_MMA(1, 0, At, B0); BAR; SCHED;
        G_STB(0, 1, t + 2);
        WAIT_V(6); BAR; G_MMA(1, 1, At, B1); BAR;
        G_LDB(B0, 1, 0); SCHED; G_LDA(At, 1, 0); G_STA(0, 1, t + 2);
        WAIT_L(8); BAR; WAIT_L(0); G_MMA(0, 0, At, B0); BAR; SCHED;
        G_LDB(B1, 1, 1); G_STB(1, 0, t + 3);
        BAR; WAIT_L(0); G_MMA(0, 1, At, B1); BAR;
        G_LDA(At, 1, 1); G_STA(1, 0, t + 3);
        BAR; WAIT_L(0); G_MMA(1, 0, At, B0); BAR; SCHED;
        G_STB(1, 1, t + 3);
        WAIT_V(6); BAR; G_MMA(1, 1, At, B1); BAR;
    }
    { G_LDB(B0, 0, 0); G_LDA(At, 0, 0); G_STA(1, 1, nt - 1);
      BAR; WAIT_L(0); G_MMA(0, 0, At, B0); BAR;
      G_LDB(B1, 0, 1); BAR; WAIT_L(0); G_MMA(0, 1, At, B1); BAR;
      G_LDA(At, 0, 1); WAIT_V(4); BAR; WAIT_L(0); G_MMA(1, 0, At, B0); G_MMA(1, 1, At, B1); BAR; }
    { G_LDB(B0, 1, 0); G_LDA(At, 1, 0); WAIT_V(2); BAR; WAIT_L(0); G_MMA(0, 0, At, B0); BAR;
      G_LDB(B1, 1, 1); WAIT_V(0); BAR; WAIT_L(0); G_MMA(0, 1, At, B1); BAR;
      G_LDA(At, 1, 1); BAR; WAIT_L(0); G_MMA(1, 0, At, B0); G_MMA(1, 1, At, B1); BAR; }
    if (wr == 0) BAR;
    asm volatile("" ::: "memory");
    int tid_e = threadIdx.x; asm volatile("" : "+v"(tid_e));
    const int e_wid = tid_e >> 6, e_lane = tid_e & 63; const int e_wr = e_wid >> 2, e_wc = e_wid & 3, e_fr = e_lane & 15, e_fq = e_lane >> 4;
    Epi ep; ep.dst = (bf16_t*)(ws + OFF_PROJ); ep.ldd = NIN; ep.aux = nullptr; ep.rope = (const float2*)(ws + OFF_ROPE); ep.fac = 1.f; ep.tr = TR_NONE;
    if (kind == GK_IN_EVEN) {
        if (pn < 2) { ep.tr = TR_SCALE; ep.fac = 0.125f; }
        else if (pn == 6 || pn == 7) { ep.tr = TR_SSQ; ep.aux = (float*)(ws + OFF_SSQ) + (size_t)(li * 2 + (pn - 6)) * T; }
        else if (pn >= 8 && pn < 12) ep.tr = TR_SILU;
        else if (pn == 12) ep.tr = TR_ROPEKR;
    } else if (kind == GK_IN_ODD) {
        if (pn < 2 || pn == 3 || pn == 4) { ep.tr = TR_SCALE; ep.fac = 0.125f * LOG2E; }
        else if (pn >= 9) ep.tr = TR_SILU;
    } else if (kind == GK_UPQ) {
        ep.tr = TR_UPQ; ep.fac = 0.10206207261596577f * LOG2E; ep.dst = (bf16_t*)(ws + OFF_QM); ep.ldd = 768; ep.aux = (float*)(ws + OFF_SSQ) + (size_t)(li * 2) * T;
    } else if (kind == GK_UPKV) {
        ep.tr = TR_UPKV; ep.fac = 1.f; ep.dst = (bf16_t*)(ws + OFF_HB); ep.ldd = 1024; ep.aux = (float*)(ws + OFF_SSQ) + (size_t)(li * 2 + 1) * T;
    } else { ep.tr = TR_OUT; ep.aux = (float*)(ws + OFF_H); }
    const int tr = ep.tr;
#pragma unroll
    for (int ai = 0; ai < 2; ++ai)
#pragma unroll
        for (int m = 0; m < 4; ++m) {
            const int row = pm * 256 + ai * 128 + e_wr * 64 + m * 16 + e_fr;
            float rs = ep.fac, ss = 0.f;
            if (tr == TR_UPQ || tr == TR_UPKV) rs = ep.fac / sqrtf(ep.aux[row] * (1.0f / 256.0f) + 1e-6f);
            const int pp = row % LPAD;
#pragma unroll
            for (int bj = 0; bj < 2; ++bj)
#pragma unroll
                for (int n = 0; n < 2; ++n) {
                    const int col = pn * 256 + bj * 128 + e_wc * 32 + n * 16 + 4 * e_fq;
                    f32x4 v = acc[ai][bj][m][n];
                    if (tr == TR_OUT) {
                        float* hp = ep.aux + (size_t)row * DM + col; const f32x4 hv = *(const f32x4*)hp;
                        *(f32x4*)hp = hv * DN_ALPHA + v;
                    } else {
                        if (tr == TR_SCALE || tr == TR_UPKV) v = v * rs;
                        else if (tr == TR_SILU) { v[0] = silu_f(v[0]); v[1] = silu_f(v[1]); v[2] = silu_f(v[2]); v[3] = silu_f(v[3]); }
                        else if (tr == TR_SSQ) ss += v[0] * v[0] + v[1] * v[1] + v[2] * v[2] + v[3] * v[3];
                        else if (tr == TR_ROPEKR) {
                            const int rc = col - E_KR;
                            if (rc < 32) { const float2 c0 = ep.rope[pp * 16 + (rc >> 1)], c1 = ep.rope[pp * 16 + (rc >> 1) + 1];
                                const float a0 = v[0] * c0.x - v[1] * c0.y, b0 = v[1] * c0.x + v[0] * c0.y, a1 = v[2] * c1.x - v[3] * c1.y, b1 = v[3] * c1.x + v[2] * c1.y;
                                v = (f32x4){a0, b0, a1, b1}; }
                        } else if (tr == TR_UPQ) {
                            v = v * rs; const int rc = (col % 96) - 64;
                            if (rc >= 0) { const float2 c0 = ep.rope[pp * 16 + (rc >> 1)], c1 = ep.rope[pp * 16 + (rc >> 1) + 1];
                                const float a0 = v[0] * c0.x - v[1] * c0.y, b0 = v[1] * c0.x + v[0] * c0.y, a1 = v[2] * c1.x - v[3] * c1.y, b1 = v[3] * c1.x + v[2] * c1.y;
                                v = (f32x4){a0, b0, a1, b1}; }
                        }
                        if (!(tr == TR_ROPEKR && col >= E_KR + 32)) store4bf(ep.dst + (size_t)row * ep.ldd + col, v);
                    }
                }
            if (tr == TR_SSQ) { ss += shx(ss, 16, e_lane); ss += shx(ss, 32, e_lane); if (e_fq == 0) atomicAdd(ep.aux + row, ss); }
            SCHED;
        }
}

enum { M_SB = 0, M_MLA = 1, M_SWA = 2, M_FOX = 3 };
constexpr int ATT_FLAGS = 2 * (12288 + 8192);
constexpr int ATT_UTMP = ATT_FLAGS + 64;
constexpr int ATT_UOFF = ATT_UTMP + 544;
constexpr int ATT_CB = ATT_UOFF + 544 + 384;
#define MFMA32(a, b, c) __builtin_amdgcn_mfma_f32_32x32x16_bf16(a, b, c, 0, 0, 0)
__device__ __forceinline__ s16x4 vtr(const LAS unsigned char* p) { return __builtin_bit_cast(s16x4, __builtin_amdgcn_ds_read_tr16_b64_v4i16((LAS s16x4*)p)); }

template <int MODE>
__device__ __forceinline__ void attn_unit(const Params& P, LAS unsigned char* lds, int li, int b, int h, int qt) {
    constexpr int DK = (MODE == M_MLA) ? 96 : 64, NKS = DK / 16, KBYTES = (DK / 8) * 1024, BUFB = KBYTES + 8192;
    int tid = threadIdx.x; asm volatile("" : "+v"(tid));
    const int lane = tid & 63, r32 = lane & 31, hi = lane >> 5;
    const int wid = __builtin_amdgcn_readfirstlane(tid >> 6);
    unsigned char* wsa = P.ws; asm volatile("" : "+s"(wsa));
    bf16_t* proj = (bf16_t*)(wsa + OFF_PROJ);
    const bf16_t* qm = (const bf16_t*)(wsa + OFF_QM);
    const bf16_t* kvb = (const bf16_t*)(wsa + OFF_HB);
    const size_t rowbase = (size_t)b * LPAD;
    const int q0 = qt * 256, qw0 = q0 + wid * 32, cw = qw0 >> 6, qi = qw0 + r32;
    const bool wave_on = qw0 < LPAD;
    const int jmax = (q0 + 255) / 64 < 64 ? (q0 + 255) / 64 : 64;
    int nband = jmax + 1, ntiles = jmax + 1;
    if (MODE == M_SWA) { const int jlo = (4 * qt - 2) > 1 ? (4 * qt - 2) : 1; nband = jmax - jlo + 1; ntiles = nband + 1; }
    const bf16_t *Qp, *Kp, *Vp, *K2p = nullptr; int ldq, ldk, ldv; bf16_t* Op;
    if (MODE == M_SB)       { Qp = proj + h * 64; ldq = NIN; Kp = proj + 512 + h * 64; ldk = NIN; Vp = proj + 1024 + h * 64; ldv = NIN; Op = proj + E_GATE + h * 64; }
    else if (MODE == M_MLA) { Qp = qm + h * 96; ldq = 768; Kp = kvb + h * 128; ldk = 1024; Vp = kvb + h * 128 + 64; ldv = 1024; K2p = proj + E_KR; Op = proj + E_GATE + 512 + h * 64; }
    else if (MODE == M_SWA) { Qp = proj + h * 64; ldq = NIN; Kp = proj + 512 + (h >> 2) * 64; ldk = NIN; Vp = proj + 640 + (h >> 2) * 64; ldv = NIN; Op = proj + O_GATE + h * 64; }
    else                    { Qp = proj + 768 + h * 64; ldq = NIN; Kp = proj + 1280 + h * 64; ldk = NIN; Vp = proj + 1792 + h * 64; ldv = NIN; Op = proj + O_GATE + 512 + h * 64; }

    LAS float* cb = (LAS float*)(lds + ATT_CB);
    if (MODE == M_FOX) {
        LAS float* utmp = (LAS float*)(lds + ATT_UTMP); LAS float* uo = (LAS float*)(lds + ATT_UOFF);
        const float* utot = (const float*)(wsa + OFF_UTOT) + (size_t)(b * 8 + h) * 256;
        const float* lcum = (const float*)(wsa + OFF_LCUM) + (size_t)(b * 8 + h) * LPAD;
        if (tid < NUNIT_SEQ) utmp[tid] = utot[tid];
        __syncthreads();
        if (tid < NUNIT_SEQ) { float a = 0.f; for (int i = 0; i < tid; ++i) a += utmp[i]; uo[tid] = a; }
        __syncthreads();
        const float base = uo[q0 >> 5];
        const int kend = (q0 + 256) < LPAD ? (q0 + 256) : LPAD;
        for (int s = tid; s < kend; s += 512) cb[s] = (lcum[s] + uo[s >> 5] - base) * LOG2E;
    }
    float slope2 = 0.f, sink2 = 0.f;
    if (MODE == M_SWA) { slope2 = exp2f(-(float)(h + 1)) * LOG2E; sink2 = P.sinks[li * 8 + h] * LOG2E; }

    bf16x8 qf[NKS];
#pragma unroll
    for (int ks = 0; ks < NKS; ++ks) {
        if (wave_on) qf[ks] = *(const bf16x8*)(Qp + (rowbase + qi) * ldq + ks * 16 + hi * 8);
        else qf[ks] = (bf16x8){0, 0, 0, 0, 0, 0, 0, 0};
    }
    f32x16 o[2];
#pragma unroll
    for (int r = 0; r < 16; ++r) { o[0][r] = 0.f; o[1][r] = 0.f; }
    float mrow = NEGB, lrow = 0.f, carry = 0.f;
    bool wdone = !wave_on;

    bf16x8 kreg0, kreg1, vreg;
    kreg1 = (bf16x8){0, 0, 0, 0, 0, 0, 0, 0};
#define TILE_OF(it) ((MODE == M_SWA) ? ((it) < nband ? jmax - (it) : 0) : jmax - (it))
#define GLOAD(j) do { const size_t r_ = rowbase + (size_t)64 * (j); \
        kreg0 = *(const bf16x8*)(Kp + (r_ + lane) * ldk + wid * 8); \
        if (MODE == M_MLA && wid < 4) kreg1 = *(const bf16x8*)(K2p + (r_ + lane) * NIN + wid * 8); \
        vreg = *(const bf16x8*)(Vp + (r_ + 16 * (wid & 3) + (lane >> 2)) * ldv + (wid >> 2) * 32 + (lane & 3) * 8); } while (0)
#define LWRITE(buf) do { LAS unsigned char* b_ = lds + (buf) * BUFB; \
        *(LAS bf16x8*)(b_ + wid * 1024 + lane * 16) = kreg0; \
        if (MODE == M_MLA && wid < 4) *(LAS bf16x8*)(b_ + (8 + wid) * 1024 + lane * 16) = kreg1; \
        *(LAS bf16x8*)(b_ + KBYTES + wid * 1024 + lane * 16) = vreg; } while (0)

    GLOAD(TILE_OF(0)); LWRITE(0);
    __syncthreads();
    const int vbase = KBYTES + (4 * hi + ((lane & 15) >> 2)) * 64 + ((lane >> 4) & 1) * 32 + (lane & 3) * 8;
    for (int it = 0; it < ntiles; ++it) {
        const int j = TILE_OF(it);
        if (it + 1 < ntiles) GLOAD(TILE_OF(it + 1));
        bool act = wave_on && !wdone && (j <= cw);
        if (MODE == M_SWA) act = act && (j == 0 || j >= cw - 2);
        if (act) {
            const LAS unsigned char* kb = lds + (it & 1) * BUFB;
            f32x16 s[2];
#pragma unroll
            for (int r = 0; r < 16; ++r) { s[0][r] = 0.f; s[1][r] = 0.f; }
#pragma unroll
            for (int ks = 0; ks < NKS; ++ks) {
                const bf16x8 k0 = *(const LAS bf16x8*)(kb + (2 * ks + hi) * 1024 + r32 * 16);
                const bf16x8 k1 = *(const LAS bf16x8*)(kb + (2 * ks + hi) * 1024 + (32 + r32) * 16);
                s[0] = MFMA32(k0, qf[ks], s[0]); s[1] = MFMA32(k1, qf[ks], s[1]);
            }
            const int key0 = 64 * j + 4 * hi;
            if (MODE == M_SB) {
                float tl[8], tp[8], ab[8];
                f32x16 lsv[2];
#pragma unroll
                for (int n = 0; n < 2; ++n)
#pragma unroll
                    for (int g = 0; g < 4; ++g) {
                        float tsum = 0.f;
#pragma unroll
                        for (int i = 0; i < 4; ++i) {
                            const int reg = 4 * g + i, key = key0 + 32 * n + 8 * g + i;
                            const bool valid = (key < qi) && (key >= POFF);
                            const float z = s[n][reg];
                            const float e = __expf(-fabsf(z));
                            const float sp = fmaxf(z, 0.f) + __logf(1.f + e);
                            const float l = valid ? -sp : 0.f;
                            lsv[n][reg] = l; tsum += l;
                            s[n][reg] = valid ? (z - sp) : NEGB;
                        }
                        tl[4 * n + g] = tsum;
                    }
#pragma unroll
                for (int c = 0; c < 8; ++c) tp[c] = shx(tl[c], 32, lane);
                float accs = 0.f;
#pragma unroll
                for (int c = 7; c >= 0; --c) { ab[c] = accs + (hi == 0 ? tp[c] : 0.f); accs += tl[c] + tp[c]; }
#pragma unroll
                for (int n = 0; n < 2; ++n)
#pragma unroll
                    for (int g = 0; g < 4; ++g) {
                        float a = carry + ab[4 * n + g];
#pragma unroll
                        for (int i = 3; i >= 0; --i) {
                            const int reg = 4 * g + i;
                            const float w = __expf(s[n][reg] + a);
                            a += lsv[n][reg];
                            s[n][reg] = w;
                        }
                    }
                carry += accs;
            } else {
                if (MODE == M_FOX) {
#pragma unroll
                    for (int n = 0; n < 2; ++n)
#pragma unroll
                        for (int g = 0; g < 4; ++g) { const f32x4 c4 = *(const LAS f32x4*)(cb + key0 + 32 * n + 8 * g);
#pragma unroll
                            for (int i = 0; i < 4; ++i) s[n][4 * g + i] -= c4[i]; }
                }
                if (MODE == M_SWA) {
#pragma unroll
                    for (int n = 0; n < 2; ++n)
#pragma unroll
                        for (int r = 0; r < 16; ++r) { const int key = key0 + 32 * n + 8 * (r >> 2) + (r & 3); s[n][r] -= slope2 * fabsf((float)(qi - key)); }
                }
                if (j == 0) {
#pragma unroll
                    for (int n = 0; n < 2; ++n)
#pragma unroll
                        for (int r = 0; r < 16; ++r) { const int key = key0 + 32 * n + 8 * (r >> 2) + (r & 3); if (key < POFF) s[n][r] = NEGB; }
                }
                if (MODE == M_FOX && j == cw) {
#pragma unroll
                    for (int n = 0; n < 2; ++n)
#pragma unroll
                        for (int r = 0; r < 16; ++r) { const int key = key0 + 32 * n + 8 * (r >> 2) + (r & 3); if (key > qi) s[n][r] = NEGB; }
                }
                float mx = s[0][0];
#pragma unroll
                for (int r = 1; r < 16; ++r) mx = fmaxf(mx, s[0][r]);
#pragma unroll
                for (int r = 0; r < 16; ++r) mx = fmaxf(mx, s[1][r]);
                mx = fmaxf(mx, shx(mx, 32, lane));
                const float mnew = fmaxf(mrow, mx);
                const float alpha = __builtin_amdgcn_exp2f(mrow - mnew);
                mrow = mnew;
                float psum = 0.f;
#pragma unroll
                for (int n = 0; n < 2; ++n)
#pragma unroll
                    for (int r = 0; r < 16; ++r) { const float pv = __builtin_amdgcn_exp2f(s[n][r] - mnew); s[n][r] = pv; psum += pv; }
                lrow = lrow * alpha + psum;
#pragma unroll
                for (int r = 0; r < 16; ++r) { o[0][r] *= alpha; o[1][r] *= alpha; }
            }
#pragma unroll
            for (int n = 0; n < 2; ++n)
#pragma unroll
                for (int sp = 0; sp < 2; ++sp) {
                    u32x4 pw; pw.x = cvtpk(s[n][8 * sp + 0], s[n][8 * sp + 1]); pw.y = cvtpk(s[n][8 * sp + 2], s[n][8 * sp + 3]);
                    pw.z = cvtpk(s[n][8 * sp + 4], s[n][8 * sp + 5]); pw.w = cvtpk(s[n][8 * sp + 6], s[n][8 * sp + 7]);
                    const bf16x8 pb = __builtin_bit_cast(bf16x8, pw);
#pragma unroll
                    for (int db = 0; db < 2; ++db) {
                        const LAS unsigned char* vp = kb + vbase + db * 4096 + (32 * n + 16 * sp) * 64;
                        const s16x4 vlo = vtr(vp), vhi = vtr(vp + 8 * 64);
                        const bf16x8 va = (bf16x8){vlo[0], vlo[1], vlo[2], vlo[3], vhi[0], vhi[1], vhi[2], vhi[3]};
                        o[db] = MFMA32(va, pb, o[db]);
                    }
                }
        }
        if (MODE == M_SB) {
            const bool dn = !wave_on || (__builtin_amdgcn_ballot_w64(carry < -120.f) == ~0ull);
            wdone = dn;
            if (lane == 0) ((LAS unsigned*)(lds + ATT_FLAGS))[(it & 1) * 8 + wid] = dn ? 1u : 0u;
        }
        if (it + 1 < ntiles) LWRITE((it + 1) & 1);
        __syncthreads();
        if (MODE == M_SB) {
            const LAS unsigned* fl = (const LAS unsigned*)(lds + ATT_FLAGS) + (it & 1) * 8;
            const unsigned all = fl[0] & fl[1] & fl[2] & fl[3] & fl[4] & fl[5] & fl[6] & fl[7];
            if (all) break;
        }
    }
    __syncthreads();
    if (wave_on) {
        float inv = 1.f;
        if (MODE != M_SB) { float lt = lrow + shx(lrow, 32, lane); if (MODE == M_SWA) lt += __builtin_amdgcn_exp2f(sink2 - mrow); inv = 1.f / lt; }
        bf16_t* orow = Op + (rowbase + qi) * NIN;
#pragma unroll
        for (int db = 0; db < 2; ++db)
#pragma unroll
            for (int g = 0; g < 4; ++g) {
                bf16_t* p = orow + 32 * db + 8 * g + 4 * hi;
                const u32x2 gw = *(const u32x2*)p;
                const float g0 = __uint_as_float(gw.x << 16), g1 = __uint_as_float(gw.x & 0xffff0000u), g2 = __uint_as_float(gw.y << 16), g3 = __uint_as_float(gw.y & 0xffff0000u);
                f32x4 v = (f32x4){o[db][4 * g + 0] * inv * g0, o[db][4 * g + 1] * inv * g1, o[db][4 * g + 2] * inv * g2, o[db][4 * g + 3] * inv * g3};
                store4bf(p, v);
            }
    }
#undef TILE_OF
#undef GLOAD
#undef LWRITE
}

template <class CM>
__device__ __forceinline__ void convert_T(LAS unsigned char* lds, const float* src, int lds_src, bf16_t* dst, int K, int Nd, const float* kscale, CM cm) {
    LAS float* tile = (LAS float*)lds;
    const int tid = threadIdx.x, tk = K / 64, tn = Nd / 64;
    for (int t = blockIdx.x; t < tk * tn; t += gridDim.x) {
        const int k0 = (t % tk) * 64, n0 = (t / tk) * 64;
#pragma unroll
        for (int i = 0; i < 8; ++i) {
            const int kk = i * 8 + (tid >> 6), nn = tid & 63; const int sc = cm(n0 + nn);
            float v = sc >= 0 ? src[(size_t)(k0 + kk) * lds_src + sc] : 0.f;
            if (kscale) v *= kscale[k0 + kk];
            tile[kk * 65 + nn] = v;
        }
        __syncthreads();
        { const int nn = tid >> 3, kc = (tid & 7) * 8; u32x4 w;
          w.x = cvtpk(tile[(kc + 0) * 65 + nn], tile[(kc + 1) * 65 + nn]); w.y = cvtpk(tile[(kc + 2) * 65 + nn], tile[(kc + 3) * 65 + nn]);
          w.z = cvtpk(tile[(kc + 4) * 65 + nn], tile[(kc + 5) * 65 + nn]); w.w = cvtpk(tile[(kc + 6) * 65 + nn], tile[(kc + 7) * 65 + nn]);
          *(u32x4*)(dst + (size_t)(n0 + nn) * K + k0 + kc) = w; }
        __syncthreads();
    }
}
struct CmIdent { __device__ __forceinline__ int operator()(int n) const { return n; } };
struct CmEvenIn { __device__ __forceinline__ int operator()(int n) const { if (n < 2048) return n; if (n < 3072) return n + 32; if (n < 3104) { const int rc = n - 3072; return 2048 + (rc >> 1) + 16 * (rc & 1); } return -1; } };
struct CmOddIn { __device__ __forceinline__ int operator()(int n) const { return n < 2304 ? n : n + 8; } };
struct CmUq { __device__ __forceinline__ int operator()(int n) const { const int hh = n / 96, c = n % 96; if (c < 64) return n; const int rc = c - 64; return hh * 96 + 64 + (rc >> 1) + 16 * (rc & 1); } };

__device__ __forceinline__ void prep_phase(const Params& P, LAS unsigned char* lds) {
    unsigned char* ws = P.ws;
    for (int i = 0; i < 2; ++i) {
        convert_T(lds, P.w_in_even + (size_t)i * DM * SRC_EVEN_IN, SRC_EVEN_IN, (bf16_t*)(ws + OFF_WINE + i * SZ_WIN), DM, NIN, nullptr, CmEvenIn());
        convert_T(lds, P.w_in_odd + (size_t)i * DM * SRC_ODD_IN, SRC_ODD_IN, (bf16_t*)(ws + OFF_WINO + i * SZ_WIN), DM, NIN, nullptr, CmOddIn());
        convert_T(lds, P.w_out_even + (size_t)i * DM * DM, DM, (bf16_t*)(ws + OFF_WOUTE + i * SZ_WOUT), DM, DM, nullptr, CmIdent());
        convert_T(lds, P.w_out_odd + (size_t)i * DM * DM, DM, (bf16_t*)(ws + OFF_WOUTO + i * SZ_WOUT), DM, DM, nullptr, CmIdent());
        convert_T(lds, P.w_uq + (size_t)i * 256 * 768, 768, (bf16_t*)(ws + OFF_WUQ + i * SZ_WUQ), 256, 768, P.g_cq + i * 256, CmUq());
        convert_T(lds, P.w_ukv + (size_t)i * 256 * 1024, 1024, (bf16_t*)(ws + OFF_WUKV + i * SZ_WUKV), 256, 1024, P.g_ckv + i * 256, CmIdent());
    }
    const size_t gtid = (size_t)blockIdx.x * 512 + threadIdx.x, gn = (size_t)gridDim.x * 512;
    float* H = (float*)(ws + OFF_H); bf16_t* HB = (bf16_t*)(ws + OFF_HB);
    for (size_t idx = gtid; idx < (size_t)T * 256; idx += gn) {
        const int row = (int)(idx >> 8), c4 = (int)(idx & 255), b = row / LPAD, pp = row % LPAD;
        f32x4 v = (f32x4){0.f, 0.f, 0.f, 0.f};
        if (pp >= 64) v = *(const f32x4*)(P.x + ((size_t)(b * SEQ + pp - 64)) * DM + c4 * 4);
        else if (pp >= POFF) v = *(const f32x4*)(P.meta + (size_t)(pp - POFF) * DM + c4 * 4);
        *(f32x4*)(H + (size_t)row * DM + c4 * 4) = v;
        store4bf(HB + (size_t)row * DM + c4 * 4, v);
    }
    float2* rope = (float2*)(ws + OFF_ROPE);
    for (size_t idx = gtid; idx < (size_t)LPAD * 16; idx += gn) {
        const int pp = (int)(idx >> 4), i = (int)(idx & 15); const int pos = pp >= POFF ? pp - POFF : 0;
        const float inv = powf(10000.0f, -(float)i / 16.0f); const float ang = (float)pos * inv;
        float sn, cs; sincosf(ang, &sn, &cs); rope[idx] = make_float2(cs, sn);
    }
    float* ssq = (float*)(ws + OFF_SSQ);
    for (size_t idx = gtid; idx < (size_t)4 * T; idx += gn) ssq[idx] = 0.f;
}

__device__ __forceinline__ void ln_phase(const Params& P, LAS unsigned char* lds, int layer, bool fz, int fi, bool last) {
    int tid = threadIdx.x; asm volatile("" : "+v"(tid));
    const int lane = tid & 63, wid = tid >> 6;
    unsigned char* ws = P.ws; asm volatile("" : "+s"(ws));
    float* H = (float*)(ws + OFF_H); bf16_t* HB = (bf16_t*)(ws + OFF_HB);
    LAS float* wfz = (LAS float*)lds;
    LAS float* lc = (LAS float*)(lds + 32768);
    LAS float* wt = (LAS float*)(lds + 32768 + 1024);
    if (fz) {
        const float* src = P.w_in_odd + (size_t)fi * DM * SRC_ODD_IN + 2304;
        for (int e = tid; e < 8192; e += 512) wfz[e] = src[(size_t)(e >> 3) * SRC_ODD_IN + (e & 7)];
        __syncthreads();
    }
    const float* gain = P.ln_gain + layer * DM; const float* bias = P.ln_bias + layer * DM;
    f32x4 gv[4], bv[4];
#pragma unroll
    for (int i = 0; i < 4; ++i) { gv[i] = *(const f32x4*)(gain + 4 * lane + 256 * i); bv[i] = *(const f32x4*)(bias + 4 * lane + 256 * i); }
    float bfg[8];
#pragma unroll
    for (int hd = 0; hd < 8; ++hd) bfg[hd] = fz ? P.b_forget[fi * 8 + hd] : 0.f;
    for (int unit = blockIdx.x; unit < T / 32; unit += gridDim.x) {
        float run[8];
#pragma unroll
        for (int hd = 0; hd < 8; ++hd) run[hd] = 0.f;
        for (int rr = 0; rr < 4; ++rr) {
            const int row = unit * 32 + wid * 4 + rr, b = row / LPAD, pp = row % LPAD;
            float* hp = H + (size_t)row * DM;
            f32x4 v[4]; float s = 0.f;
#pragma unroll
            for (int i = 0; i < 4; ++i) { v[i] = *(const f32x4*)(hp + 4 * lane + 256 * i); s += (v[i][0] + v[i][1]) + (v[i][2] + v[i][3]); }
#pragma unroll
            for (int o = 1; o < 64; o <<= 1) s += shx(s, o, lane);
            const float mu = s * (1.0f / 1024.0f); float q = 0.f;
#pragma unroll
            for (int i = 0; i < 4; ++i) { v[i] = v[i] - mu; q += (v[i][0] * v[i][0] + v[i][1] * v[i][1]) + (v[i][2] * v[i][2] + v[i][3] * v[i][3]); }
#pragma unroll
            for (int o = 1; o < 64; o <<= 1) q += shx(q, o, lane);
            const float rstd = 1.0f / sqrtf(q * (1.0f / 1024.0f) + 1e-5f);
#pragma unroll
            for (int i = 0; i < 4; ++i) v[i] = v[i] * rstd * gv[i] + bv[i];
            if (last) {
                if (pp >= 64) { float* op = P.out + ((size_t)(b * SEQ + pp - 64)) * DM;
#pragma unroll
                    for (int i = 0; i < 4; ++i) *(f32x4*)(op + 4 * lane + 256 * i) = v[i]; }
            } else {
#pragma unroll
                for (int i = 0; i < 4; ++i) { *(f32x4*)(hp + 4 * lane + 256 * i) = v[i]; store4bf(HB + (size_t)row * DM + 4 * lane + 256 * i, v[i]); }
            }
            if (fz) {
                float d[8];
#pragma unroll
                for (int hd = 0; hd < 8; ++hd) d[hd] = 0.f;
#pragma unroll
                for (int i = 0; i < 4; ++i)
#pragma unroll
                    for (int e = 0; e < 4; ++e) {
                        const LAS float* wp = wfz + (4 * lane + 256 * i + e) * 8; const f32x4 w0 = *(const LAS f32x4*)wp, w1 = *(const LAS f32x4*)(wp + 4);
                        const float y = v[i][e];
                        d[0] += y * w0[0]; d[1] += y * w0[1]; d[2] += y * w0[2]; d[3] += y * w0[3]; d[4] += y * w1[0]; d[5] += y * w1[1]; d[6] += y * w1[2]; d[7] += y * w1[3];
                    }
#pragma unroll
                for (int hd = 0; hd < 8; ++hd) {
                    float a = d[hd];
#pragma unroll
                    for (int o = 1; o < 64; o <<= 1) a += shx(a, o, lane);
                    const float xx = a + bfg[hd];
                    const float lf = fminf(xx, 0.f) - log1pf(expf(-fabsf(xx)));
                    run[hd] += lf;
                    if (lane == 0) lc[(wid * 4 + rr) * 8 + hd] = run[hd];
                }
            }
        }
        if (fz) {
            if (lane == 0) {
#pragma unroll
                for (int hd = 0; hd < 8; ++hd) wt[wid * 8 + hd] = run[hd];
            }
            __syncthreads();
            const int b = (unit * 32) / LPAD, pp0 = (unit * 32) % LPAD;
            if (tid < 256) {
                const int r = tid >> 3, hd = tid & 7, w = r >> 2; float off = 0.f;
                for (int w2 = 0; w2 < w; ++w2) off += wt[w2 * 8 + hd];
                ((float*)(ws + OFF_LCUM))[(size_t)(b * 8 + hd) * LPAD + pp0 + r] = lc[r * 8 + hd] + off;
            }
            if (tid < 8) { float tt = 0.f; for (int w2 = 0; w2 < 8; ++w2) tt += wt[w2 * 8 + tid]; ((float*)(ws + OFF_UTOT))[(size_t)(b * 8 + tid) * 256 + (pp0 >> 5)] = tt; }
            __syncthreads();
        }
    }
}

__global__ void __launch_bounds__(512) fwd_megakernel(Params P) {
    extern __shared__ __attribute__((aligned(16))) unsigned char lds_raw[];
    LAS unsigned char* lds = (LAS unsigned char*)lds_raw;
    cg::grid_group grid = cg::this_grid();
    unsigned char* ws = P.ws;
    const int G = gridDim.x, bid = blockIdx.x;
    bf16_t* proj = (bf16_t*)(ws + OFF_PROJ);
    const float2* rope = (const float2*)(ws + OFF_ROPE);

#ifndef NO_PREP
    prep_phase(P, lds);
#endif
    grid.sync();

    for (int layer = 0; layer < 4; ++layer) {
        const int li = layer >> 1; const bool even = (layer & 1) == 0;
        {
            TileOrder ord; ord.init(NMT, 13);
            for (int i = 0;; ++i) {
                int pm, pn; if (!ord.get(i * G + bid, pm, pn)) break;
#ifndef NO_GEMM
                gemm_unit(lds, ws, even ? GK_IN_EVEN : GK_IN_ODD, li, pm, pn);
#endif
            }
        }
        grid.sync();
        if (even) {
            for (int u = bid; u < NMT * 7; u += G) {
                int kind, pm, pn;
                if (u < NMT * 3) { kind = GK_UPQ; pm = u / 3; pn = u % 3; } else { const int u2 = u - NMT * 3; kind = GK_UPKV; pm = u2 / 4; pn = u2 % 4; }
#ifndef NO_GEMM
                gemm_unit(lds, ws, kind, li, pm, pn);
#endif
            }
            grid.sync();
        }
        for (int r = 0; r * G < 2176; ++r) {
            const int s = r * G + ((r & 1) ? (G - 1 - bid) : bid);
            if (s >= 2176) continue;
            const bool heavy = s < 1088; const int idx = heavy ? s : s - 1088;
            const int qt = 16 - idx / 64, bh = idx % 64, b = bh >> 3, h = bh & 7;
#ifndef NO_ATTN
            if (even) { if (heavy) attn_unit<M_MLA>(P, lds, li, b, h, qt); else attn_unit<M_SB>(P, lds, li, b, h, qt); }
            else      { if (heavy) attn_unit<M_FOX>(P, lds, li, b, h, qt); else attn_unit<M_SWA>(P, lds, li, b, h, qt); }
#endif
        }
        grid.sync();
        {
            TileOrder ord; ord.init(NMT, 4);
            for (int i = 0;; ++i) { int pm, pn; if (!ord.get(i * G + bid, pm, pn)) break;
#ifndef NO_GEMM
                gemm_unit(lds, ws, even ? GK_OUT_EVEN : GK_OUT_ODD, li, pm, pn);
#endif
            }
        }
        grid.sync();
#ifndef NO_LN
        ln_phase(P, lds, layer,  even,  li,  layer == 3);
#endif
        if (layer < 3) grid.sync();
    }
}

extern "C" void kernel_launch(void* const* d_in, const int* in_sizes, int n_in, void* d_out, int out_size, void* d_ws, size_t ws_size, hipStream_t stream) {
    constexpr size_t kDynLds = 131072;
    static int grid_blocks = 0;
    if (!grid_blocks) {
        int dev = 0, cus = 0, per_cu = 0;
        hipGetDevice(&dev);
        hipDeviceGetAttribute(&cus, hipDeviceAttributeMultiprocessorCount, dev);
        hipFuncSetAttribute((const void*)fwd_megakernel, hipFuncAttributeMaxDynamicSharedMemorySize, (int)kDynLds);
        hipOccupancyMaxActiveBlocksPerMultiprocessor(&per_cu, (const void*)fwd_megakernel, 512, kDynLds);
        if (per_cu < 1) per_cu = 1;
        if (per_cu > 1) per_cu = 1;
        grid_blocks = cus * per_cu;
        if (ws_size < WS_END) fprintf(stderr, "kernel_launch: workspace too small: %zu < %zu\n", ws_size, (size_t)WS_END);
    }
    Params p{};
    p.x = (const float*)d_in[0]; p.meta = (const float*)d_in[1]; p.w_in_even = (const float*)d_in[2]; p.g_cq = (const float*)d_in[3]; p.g_ckv = (const float*)d_in[4];
    p.w_uq = (const float*)d_in[5]; p.w_ukv = (const float*)d_in[6]; p.w_out_even = (const float*)d_in[7]; p.w_in_odd = (const float*)d_in[8]; p.b_forget = (const float*)d_in[9];
    p.sinks = (const float*)d_in[10]; p.w_out_odd = (const float*)d_in[11]; p.ln_gain = (const float*)d_in[12]; p.ln_bias = (const float*)d_in[13];
    p.out = (float*)d_out; p.ws = (unsigned char*)d_ws;
    void* args[] = {&p};
    hipError_t e = hipLaunchCooperativeKernel((const void*)fwd_megakernel, dim3(grid_blocks), dim3(512), args, kDynLds, stream);
    if (e != hipSuccess) fprintf(stderr, "cooperative launch failed: %s (grid %d)\n", hipGetErrorString(e), grid_blocks);
}
```

```cpp
#include <hip/hip_runtime.h>
#include <hip/hip_cooperative_groups.h>
#include <cstdio>
#include <cstdint>
namespace cg = cooperative_groups;
#ifndef REP_GEMM
#define REP_GEMM 1
#endif
#ifndef REP_ATTN
#define REP_ATTN 1
#endif
#ifndef REP_LN
#define REP_LN 1
#endif
#ifndef REP_PREP
#define REP_PREP 1
#endif

#define LAS __attribute__((address_space(3)))
typedef unsigned short bf16_t;
typedef short bf16x8 __attribute__((ext_vector_type(8)));
typedef short s16x4 __attribute__((ext_vector_type(4)));
typedef float f32x4 __attribute__((ext_vector_type(4)));
typedef float f32x16 __attribute__((ext_vector_type(16)));
typedef unsigned u32x2 __attribute__((ext_vector_type(2)));
typedef unsigned u32x4 __attribute__((ext_vector_type(4)));

constexpr int DM = 1024, NB = 8, SEQ = 4096, NMETA = 16;
constexpr int POFF = 48;
constexpr int LPAD = 4160;
constexpr int T = NB * LPAD;
constexpr int NMT = T / 256;
constexpr int NIN = 3328;
constexpr int SRC_EVEN_IN = 3104, SRC_ODD_IN = 3336;
constexpr int NUNIT_SEQ = LPAD / 32;
constexpr float LOG2E = 1.4426950408889634f;
constexpr float DN_ALPHA = 1.681792830507429f;
constexpr float NEGB = -1e30f;

constexpr int E_GATE = 2048, E_KR = 3072, O_GATE = 2304;

constexpr size_t SZ_H = (size_t)T * DM * 4, SZ_HB = (size_t)T * DM * 2, SZ_PROJ = (size_t)T * NIN * 2, SZ_QM = (size_t)T * 768 * 2;
constexpr size_t OFF_H = 0, OFF_HB = OFF_H + SZ_H, OFF_PROJ = OFF_HB + SZ_HB, OFF_QM = OFF_PROJ + SZ_PROJ, OFF_W = OFF_QM + SZ_QM;
constexpr size_t SZ_WIN = (size_t)NIN * DM * 2, SZ_WUQ = 768 * 256 * 2, SZ_WUKV = 1024 * 256 * 2, SZ_WOUT = (size_t)DM * DM * 2;
constexpr size_t OFF_WINE = OFF_W, OFF_WUQ = OFF_WINE + 2 * SZ_WIN, OFF_WUKV = OFF_WUQ + 2 * SZ_WUQ, OFF_WOUTE = OFF_WUKV + 2 * SZ_WUKV,
                 OFF_WINO = OFF_WOUTE + 2 * SZ_WOUT, OFF_WOUTO = OFF_WINO + 2 * SZ_WIN, OFF_SSQ = OFF_WOUTO + 2 * SZ_WOUT;
constexpr size_t SZ_SSQ = (size_t)4 * T * 4;
constexpr size_t OFF_LCUM = OFF_SSQ + SZ_SSQ, SZ_LCUM = (size_t)NB * 8 * LPAD * 4;
constexpr size_t OFF_UTOT = OFF_LCUM + SZ_LCUM, SZ_UTOT = (size_t)NB * 8 * 256 * 4;
constexpr size_t OFF_ROPE = OFF_UTOT + SZ_UTOT, SZ_ROPE = (size_t)LPAD * 16 * 8;
constexpr size_t OFF_BAR = OFF_ROPE + SZ_ROPE, SZ_BAR = 16384;
constexpr size_t WS_END = OFF_BAR + SZ_BAR;

struct Params {
    const float *x, *meta, *w_in_even, *g_cq, *g_ckv, *w_uq, *w_ukv, *w_out_even, *w_in_odd, *b_forget, *sinks, *w_out_odd, *ln_gain, *ln_bias;
    float* out; unsigned char* ws;
};

__device__ __forceinline__ unsigned cvtpk(float lo, float hi) { unsigned r; asm volatile("v_cvt_pk_bf16_f32 %0, %1, %2" : "=v"(r) : "v"(lo), "v"(hi)); return r; }
__device__ __forceinline__ float shx(float v, int mask, int lane) { return __int_as_float(__builtin_amdgcn_ds_bpermute((lane ^ mask) << 2, __float_as_int(v))); }
__device__ __forceinline__ int crow(int r, int hi) { return (r & 3) + 8 * (r >> 2) + 4 * hi; }
__device__ __forceinline__ float silu_f(float x) { return x / (1.f + __expf(-x)); }
__device__ __forceinline__ void store4bf(bf16_t* p, f32x4 v) { u32x2 w; w.x = cvtpk(v[0], v[1]); w.y = cvtpk(v[2], v[3]); *(u32x2*)p = w; }


#define XB_TMO      128
#define XB_XCNT(j)  (256  + 64 * (j))
#define XB_XSUB(j)  (1280 + 64 * (j))
#define XB_XGEN(j)  (2304 + 64 * (j))
#define XB_TOP      3328
#define XB_TOPGEN   3392
#define XCD_BAR_WORDS 3456
#define XB_SPIN_CAP (1u << 18)
__device__ __forceinline__ unsigned xb_ld(unsigned* p)              { return __hip_atomic_load(p, __ATOMIC_RELAXED, __HIP_MEMORY_SCOPE_AGENT); }
__device__ __forceinline__ unsigned xb_add(unsigned* p, unsigned v) { return __hip_atomic_fetch_add(p, v, __ATOMIC_RELAXED, __HIP_MEMORY_SCOPE_AGENT); }
__device__ __forceinline__ unsigned xb_xcc_id() { return (unsigned)__builtin_amdgcn_s_getreg((3 << 11) | 20) & 0xFu; }
#define XB_SPIN(cond, bar) do { unsigned _sp = 0; while (cond) { __builtin_amdgcn_s_sleep(1); \
    if ((++_sp & 255u) == 0u) { if (xb_ld(&(bar)[XB_TMO])) break; if (_sp > XB_SPIN_CAP) { atomicAdd(&(bar)[XB_TMO], 1u); break; } } } } while (0)
struct XcdBarrier { unsigned* bar; unsigned x; volatile LAS unsigned* st; };
__device__ __forceinline__ XcdBarrier xcd_barrier_post(unsigned* bar, volatile LAS unsigned* st) {
    XcdBarrier b; b.bar = bar; b.x = xb_xcc_id(); b.st = st;
    if (threadIdx.x == 0) (void)xb_add(&bar[XB_XCNT(b.x)], 1u);
    return b;
}
__device__ __forceinline__ void xcd_barrier_complete(unsigned* bar, unsigned x, unsigned& nloc, unsigned& nx) {
    const unsigned G = gridDim.x * gridDim.y * gridDim.z;
    unsigned sum, cnt, mine, sp = 0u;
    for (;;) {
        sum = 0u; cnt = 0u; mine = 0u;
#pragma unroll
        for (unsigned j = 0; j < 16; ++j) { const unsigned c = xb_ld(&bar[XB_XCNT(j)]); sum += c; cnt += (c > 0u) ? 1u : 0u; mine = (j == x) ? c : mine; }
        if (sum == G) break;
        __builtin_amdgcn_s_sleep(1);
        if ((++sp & 255u) == 0u) { if (xb_ld(&bar[XB_TMO])) break; if (sp > XB_SPIN_CAP) { atomicAdd(&bar[XB_TMO], 1u); break; } }
    }
    nloc = mine > 0u ? mine : 1u; nx = cnt > 0u ? cnt : 1u;
}
__device__ __forceinline__ void xcd_barrier(const XcdBarrier& b) {
    asm volatile("s_waitcnt vmcnt(0)" ::: "memory");
    __syncthreads();
    if (threadIdx.x == 0) {
        unsigned* bar = b.bar;
        __builtin_amdgcn_s_waitcnt(0);
        unsigned nloc = b.st[0], nx = b.st[1];
        if (nloc == 0u) { xcd_barrier_complete(bar, b.x, nloc, nx); b.st[0] = nloc; b.st[1] = nx; }
        const unsigned old = xb_add(&bar[XB_XSUB(b.x)], 1u);
        const unsigned gen = old / nloc;
        if (old + 1u == (gen + 1u) * nloc) {
            __builtin_amdgcn_fence(__ATOMIC_RELEASE, "agent");
            asm volatile("s_waitcnt vmcnt(0)" ::: "memory");
            const unsigned og = xb_add(&bar[XB_TOP], 1u);
            const unsigned tg = og / nx;
            if (og + 1u == (tg + 1u) * nx) xb_add(&bar[XB_TOPGEN], 1u);
            else XB_SPIN(xb_ld(&bar[XB_TOPGEN]) == tg, bar);
            __builtin_amdgcn_fence(__ATOMIC_ACQUIRE, "agent");
            xb_add(&bar[XB_XGEN(b.x)], 1u);
            asm volatile("s_waitcnt vmcnt(0)" ::: "memory");
        } else {
            XB_SPIN(xb_ld(&bar[XB_XGEN(b.x)]) == gen, bar);
            __builtin_amdgcn_fence(__ATOMIC_ACQUIRE, "agent");
            asm volatile("s_waitcnt vmcnt(0)" ::: "memory");
        }
    }
    __syncthreads();
}

constexpr int HTB = 128 * 64 * 2;
__device__ __forceinline__ int lds_byte(int r, int c) { const int st = (r >> 4) * 2 + (c >> 5), rr = r & 15, cc = c & 31, ob = rr * 64 + cc * 2; return st * 1024 + (ob ^ (((ob >> 9) & 1) << 5)); }
__device__ __forceinline__ void stage_rc(int b, int& R, int& C) { const int st = b / 1024, sb = b % 1024, swz = sb ^ (((sb >> 9) & 1) << 5); R = (st >> 1) * 16 + swz / 64; C = (st & 1) * 32 + (swz % 64) / 2; }

enum { TR_NONE = 0, TR_SCALE, TR_SILU, TR_SSQ, TR_ROPEKR, TR_UPQ, TR_UPKV, TR_OUT };
struct Epi { int tr; float fac; bf16_t* dst; int ldd; float* aux; const float2* rope; };

struct TileOrder {
    int nM, nN, nwg;
    __device__ __forceinline__ void init(int nM_, int nN_) { nM = nM_; nN = nN_; nwg = nM * nN; }
    __device__ __forceinline__ bool get(int L, int& pm, int& pn) const {
        if (L >= nwg) return false;
        int wgid = L; { const int q = nwg / 8, r = nwg % 8, xcd = wgid % 8, off = wgid / 8; wgid = (xcd < r ? xcd * (q + 1) : r * (q + 1) + (xcd - r) * q) + off; }
        const int nig = 8 * nN, gid = wgid / nig, fm = gid * 8, gsz = (nM - fm) < 8 ? (nM - fm) : 8;
        pm = fm + ((wgid % nig) % gsz); pn = (wgid % nig) / gsz; return true;
    }
};

#define G_SA(b, h) (((b) * 2 + (h)) * HTB)
#define G_SB(b, h) ((4 + (b) * 2 + (h)) * HTB)
#define G_STAGE(bufoff, gbase, voff, qstep) do { _Pragma("unroll") for (int _i = 0; _i < 2; ++_i) \
    __builtin_amdgcn_global_load_lds((const unsigned*)((const char*)(gbase) + (size_t)_i * (qstep) + (voff)), (LAS unsigned*)(lds + (bufoff) + ldsw + _i * 8192), 16, 0, 0); } while (0)
#define G_STA(b, h, kt) G_STAGE(G_SA(b, h), Ab + (size_t)(h) * hstepA + (size_t)(kt) * 128, voffA, qstepA)
#define G_STB(b, h, kt) G_STAGE(G_SB(b, h), Bb + (size_t)(h) * hstepB + (size_t)(kt) * 128, voffB, qstepB)
#define G_LDA(dst, b, h) do { _Pragma("unroll") for (int m = 0; m < 4; ++m) _Pragma("unroll") for (int k = 0; k < 2; ++k) dst[m][k] = *(const LAS bf16x8*)(lds + G_SA(b, h) + aoff + m * 2048 + k * 1024); } while (0)
#define G_LDB(dst, b, h) do { _Pragma("unroll") for (int n = 0; n < 2; ++n) _Pragma("unroll") for (int k = 0; k < 2; ++k) dst[n][k] = *(const LAS bf16x8*)(lds + G_SB(b, h) + boff + n * 2048 + k * 1024); } while (0)
#define G_MMA(ai, bj, At, Bt) do { __builtin_amdgcn_s_setprio(1); _Pragma("unroll") for (int m = 0; m < 4; ++m) _Pragma("unroll") for (int n = 0; n < 2; ++n) _Pragma("unroll") for (int k = 0; k < 2; ++k) \
    acc[ai][bj][m][n] = __builtin_amdgcn_mfma_f32_16x16x32_bf16(Bt[n][k], At[m][k], acc[ai][bj][m][n], 0, 0, 0); __builtin_amdgcn_s_setprio(0); } while (0)
#define WAIT_V(n) asm volatile("s_waitcnt vmcnt(" #n ")" ::: "memory")
#define WAIT_L(n) asm volatile("s_waitcnt lgkmcnt(" #n ")" ::: "memory")
#define BAR __builtin_amdgcn_s_barrier()
#define SCHED __builtin_amdgcn_sched_barrier(0)

enum { GK_IN_EVEN = 0, GK_IN_ODD, GK_UPQ, GK_UPKV, GK_OUT_EVEN, GK_OUT_ODD };
__device__ __forceinline__ void gemm_unit(LAS unsigned char* lds, unsigned char* ws, int kind_, int li_, int pm_, int pn_, bool dry = false, const float* x0 = nullptr, const float* meta0 = nullptr) {
    asm volatile("" : "+s"(ws));
    const int kind = __builtin_amdgcn_readfirstlane(kind_), li = __builtin_amdgcn_readfirstlane(li_), pm = __builtin_amdgcn_readfirstlane(pm_), pn = __builtin_amdgcn_readfirstlane(pn_);
    int tid = threadIdx.x; asm volatile("" : "+v"(tid));
    const int wid = __builtin_amdgcn_readfirstlane(tid >> 6), lane = tid & 63, wr = wid >> 2, wc = wid & 3, fr = lane & 15, fq = lane >> 4;
    const bf16_t* A; const bf16_t* Bt; int lda, ldb, K;
    {
        const bf16_t* proj = (const bf16_t*)(ws + OFF_PROJ);
        if (kind == GK_IN_EVEN)       { A = (const bf16_t*)(ws + OFF_HB); lda = DM; Bt = (const bf16_t*)(ws + OFF_WINE + li * SZ_WIN); ldb = DM; K = DM; }
        else if (kind == GK_IN_ODD)   { A = (const bf16_t*)(ws + OFF_HB); lda = DM; Bt = (const bf16_t*)(ws + OFF_WINO + li * SZ_WIN); ldb = DM; K = DM; }
        else if (kind == GK_UPQ)      { A = proj + 1536; lda = NIN; Bt = (const bf16_t*)(ws + OFF_WUQ + li * SZ_WUQ); ldb = 256; K = 256; }
        else if (kind == GK_UPKV)     { A = proj + 1792; lda = NIN; Bt = (const bf16_t*)(ws + OFF_WUKV + li * SZ_WUKV); ldb = 256; K = 256; }
        else if (kind == GK_OUT_EVEN) { A = proj + E_GATE; lda = NIN; Bt = (const bf16_t*)(ws + OFF_WOUTE + li * SZ_WOUT); ldb = DM; K = DM; }
        else                          { A = proj + O_GATE; lda = NIN; Bt = (const bf16_t*)(ws + OFF_WOUTO + li * SZ_WOUT); ldb = DM; K = DM; }
    }
    unsigned voffA, voffB;
    { int R, C; stage_rc(tid * 16, R, C); voffA = (unsigned)((R * lda + C) * 2); voffB = (unsigned)((R * ldb + C) * 2); }
    const size_t qstepA = (size_t)64 * lda * 2, qstepB = (size_t)64 * ldb * 2;
    const char* Ab = (const char*)(A + (size_t)pm * 256 * lda);
    const char* Bb = (const char*)(Bt + (size_t)pn * 256 * ldb);
    const size_t hstepA = (size_t)128 * lda * 2, hstepB = (size_t)128 * ldb * 2;
    const unsigned ldsw = (unsigned)wid * 1024u;
    const int aoff = lds_byte(wr * 64 + fr, fq * 8), boff = lds_byte(wc * 32 + fr, fq * 8);
    f32x4 acc[2][2][4][2];
#pragma unroll
    for (int a = 0; a < 2; ++a)
#pragma unroll
        for (int b = 0; b < 2; ++b)
#pragma unroll
            for (int m = 0; m < 4; ++m)
#pragma unroll
                for (int n = 0; n < 2; ++n) acc[a][b][m][n] = (f32x4){0.f, 0.f, 0.f, 0.f};
    bf16x8 At[4][2], B0[2][2], B1[2][2];
    const int nt = K / 64;
    WAIT_V(0);
    G_STB(0, 0, 0); G_STA(0, 0, 0); G_STB(0, 1, 0); G_STA(0, 1, 0);
    if (wr == 1) BAR;
    WAIT_V(4); BAR;
    G_STB(1, 0, 1); G_STA(1, 0, 1); G_STB(1, 1, 1);
    WAIT_V(6); BAR;
    for (int t = 0; t < nt - 2; t += 2) {
        G_LDB(B0, 0, 0); SCHED; G_LDA(At, 0, 0); G_STA(1, 1, t + 1);
        WAIT_L(8); BAR; WAIT_L(0); G_MMA(0, 0, At, B0); BAR; SCHED;
        G_LDB(B1, 0, 1); G_STB(0, 0, t + 2);
        BAR; WAIT_L(0); G_MMA(0, 1, At, B1); BAR;
        G_LDA(At, 0, 1); G_STA(0, 0, t + 2);
        BAR; WAIT_L(0); G_MMA(1, 0, At, B0); BAR; SCHED;
        G_STB(0, 1, t + 2);
        WAIT_V(6); BAR; G_MMA(1, 1, At, B1); BAR;
        G_LDB(B0, 1, 0); SCHED; G_LDA(At, 1, 0); G_STA(0, 1, t + 2);
        WAIT_L(8); BAR; WAIT_L(0); G_MMA(0, 0, At, B0); BAR; SCHED;
        G_LDB(B1, 1, 1); G_STB(1, 0, t + 3);
        BAR; WAIT_L(0); G_MMA(0, 1, At, B1); BAR;
        G_LDA(At, 1, 1); G_STA(1, 0, t + 3);
        BAR; WAIT_L(0); G_MMA(1, 0, At, B0); BAR; SCHED;
        G_STB(1, 1, t + 3);
        WAIT_V(6); BAR; G_MMA(1, 1, At, B1); BAR;
    }
    { G_LDB(B0, 0, 0); G_LDA(At, 0, 0); G_STA(1, 1, nt - 1);
      BAR; WAIT_L(0); G_MMA(0, 0, At, B0); BAR;
      G_LDB(B1, 0, 1); BAR; WAIT_L(0); G_MMA(0, 1, At, B1); BAR;
      G_LDA(At, 0, 1); WAIT_V(4); BAR; WAIT_L(0); G_MMA(1, 0, At, B0); G_MMA(1, 1, At, B1); BAR; }
    { G_LDB(B0, 1, 0); G_LDA(At, 1, 0); WAIT_V(2); BAR; WAIT_L(0); G_MMA(0, 0, At, B0); BAR;
      G_LDB(B1, 1, 1); WAIT_V(0); BAR; WAIT_L(0); G_MMA(0, 1, At, B1); BAR;
      G_LDA(At, 1, 1); BAR; WAIT_L(0); G_MMA(1, 0, At, B0); G_MMA(1, 1, At, B1); BAR; }
    if (wr == 0) BAR;
    asm volatile("" ::: "memory");
    int tid_e = threadIdx.x; asm volatile("" : "+v"(tid_e));
    const int e_wid = tid_e >> 6, e_lane = tid_e & 63; const int e_wr = e_wid >> 2, e_wc = e_wid & 3, e_fr = e_lane & 15, e_fq = e_lane >> 4;
    Epi ep; ep.dst = (bf16_t*)(ws + OFF_PROJ); ep.ldd = NIN; ep.aux = nullptr; ep.rope = (const float2*)(ws + OFF_ROPE); ep.fac = 1.f; ep.tr = TR_NONE;
    if (kind == GK_IN_EVEN) {
        if (pn < 2) { ep.tr = TR_SCALE; ep.fac = 0.125f; }
        else if (pn == 6 || pn == 7) { ep.tr = TR_SSQ; ep.aux = (float*)(ws + OFF_SSQ) + (size_t)(li * 2 + (pn - 6)) * T; }
        else if (pn >= 8 && pn < 12) ep.tr = TR_SILU;
        else if (pn == 12) ep.tr = TR_ROPEKR;
    } else if (kind == GK_IN_ODD) {
        if (pn < 2 || pn == 3 || pn == 4) { ep.tr = TR_SCALE; ep.fac = 0.125f * LOG2E; }
        else if (pn >= 9) ep.tr = TR_SILU;
    } else if (kind == GK_UPQ) {
        ep.tr = TR_UPQ; ep.fac = 0.10206207261596577f * LOG2E; ep.dst = (bf16_t*)(ws + OFF_QM); ep.ldd = 768; ep.aux = (float*)(ws + OFF_SSQ) + (size_t)(li * 2) * T;
    } else if (kind == GK_UPKV) {
        ep.tr = TR_UPKV; ep.fac = 1.f; ep.dst = (bf16_t*)(ws + OFF_HB); ep.ldd = 1024; ep.aux = (float*)(ws + OFF_SSQ) + (size_t)(li * 2 + 1) * T;
    } else { ep.tr = TR_OUT; ep.aux = (float*)(ws + OFF_H); }
    const int tr = ep.tr;
#pragma unroll
    for (int ai = 0; ai < 2; ++ai)
#pragma unroll
        for (int m = 0; m < 4; ++m) {
            const int row = pm * 256 + ai * 128 + e_wr * 64 + m * 16 + e_fr;
            float rs = ep.fac, ss = 0.f;
            if (tr == TR_UPQ || tr == TR_UPKV) rs = ep.fac / sqrtf(ep.aux[row] * (1.0f / 256.0f) + 1e-6f);
            const int pp = row % LPAD;
#pragma unroll
            for (int bj = 0; bj < 2; ++bj)
#pragma unroll
                for (int n = 0; n < 2; ++n) {
                    const int col = pn * 256 + bj * 128 + e_wc * 32 + n * 16 + 4 * e_fq;
                    f32x4 v = acc[ai][bj][m][n];
                    if (tr == TR_OUT) {
                        float* hp = ep.aux + (size_t)row * DM + col; f32x4 hv;
                        if (x0) {
                            hv = (f32x4){0.f, 0.f, 0.f, 0.f};
                            if (pp >= 64) hv = *(const f32x4*)(x0 + ((size_t)((row / LPAD) * SEQ + pp - 64)) * DM + col);
                            else if (pp >= POFF) hv = *(const f32x4*)(meta0 + (size_t)(pp - POFF) * DM + col);
                        } else hv = *(const f32x4*)hp;
                        if (!dry) *(f32x4*)hp = hv * DN_ALPHA + v;
                    } else {
                        if (tr == TR_SCALE || tr == TR_UPKV) v = v * rs;
                        else if (tr == TR_SILU) { v[0] = silu_f(v[0]); v[1] = silu_f(v[1]); v[2] = silu_f(v[2]); v[3] = silu_f(v[3]); }
                        else if (tr == TR_SSQ) ss += v[0] * v[0] + v[1] * v[1] + v[2] * v[2] + v[3] * v[3];
                        else if (tr == TR_ROPEKR) {
                            const int rc = col - E_KR;
                            if (rc < 32) { const float2 c0 = ep.rope[pp * 16 + (rc >> 1)], c1 = ep.rope[pp * 16 + (rc >> 1) + 1];
                                const float a0 = v[0] * c0.x - v[1] * c0.y, b0 = v[1] * c0.x + v[0] * c0.y, a1 = v[2] * c1.x - v[3] * c1.y, b1 = v[3] * c1.x + v[2] * c1.y;
                                v = (f32x4){a0, b0, a1, b1}; }
                        } else if (tr == TR_UPQ) {
                            v = v * rs; const int rc = (col % 96) - 64;
                            if (rc >= 0) { const float2 c0 = ep.rope[pp * 16 + (rc >> 1)], c1 = ep.rope[pp * 16 + (rc >> 1) + 1];
                                const float a0 = v[0] * c0.x - v[1] * c0.y, b0 = v[1] * c0.x + v[0] * c0.y, a1 = v[2] * c1.x - v[3] * c1.y, b1 = v[3] * c1.x + v[2] * c1.y;
                                v = (f32x4){a0, b0, a1, b1}; }
                        }
                        if (!(tr == TR_ROPEKR && col >= E_KR + 32)) store4bf(ep.dst + (size_t)row * ep.ldd + col, v);
                    }
                }
            if (tr == TR_SSQ) { ss += shx(ss, 16, e_lane); ss += shx(ss, 32, e_lane); if (e_fq == 0 && !dry) atomicAdd(ep.aux + row, ss); }
            SCHED;
        }
}

enum { M_SB = 0, M_MLA = 1, M_SWA = 2, M_FOX = 3 };
constexpr int ATT_FLAGS = 2 * (12288 + 8192);
constexpr int ATT_UTMP = ATT_FLAGS + 64;
constexpr int ATT_UOFF = ATT_UTMP + 544;
constexpr int ATT_CB = ATT_UOFF + 544 + 384;
#define MFMA32(a, b, c) __builtin_amdgcn_mfma_f32_32x32x16_bf16(a, b, c, 0, 0, 0)
__device__ __forceinline__ s16x4 vtr(const LAS unsigned char* p) { return __builtin_bit_cast(s16x4, __builtin_amdgcn_ds_read_tr16_b64_v4i16((LAS s16x4*)p)); }

template <int MODE>
__device__ __forceinline__ void attn_unit(const Params& P, LAS unsigned char* lds, int li, int b, int h, int qt, bool dry = false) {
    constexpr int DK = (MODE == M_MLA) ? 96 : 64, NKS = DK / 16, KBYTES = (DK / 8) * 1024, BUFB = KBYTES + 8192;
    int tid = threadIdx.x; asm volatile("" : "+v"(tid));
    const int lane = tid & 63, r32 = lane & 31, hi = lane >> 5;
    const int wid = __builtin_amdgcn_readfirstlane(tid >> 6);
    unsigned char* wsa = P.ws; asm volatile("" : "+s"(wsa));
    bf16_t* proj = (bf16_t*)(wsa + OFF_PROJ);
    const bf16_t* qm = (const bf16_t*)(wsa + OFF_QM);
    const bf16_t* kvb = (const bf16_t*)(wsa + OFF_HB);
    const size_t rowbase = (size_t)b * LPAD;
    const int q0 = qt * 256, qw0 = q0 + wid * 32, cw = qw0 >> 6, qi = qw0 + r32;
    const bool wave_on = qw0 < LPAD;
    const int jmax = (q0 + 255) / 64 < 64 ? (q0 + 255) / 64 : 64;
    int nband = jmax + 1, ntiles = jmax + 1;
    if (MODE == M_SWA) { const int jlo = (4 * qt - 2) > 1 ? (4 * qt - 2) : 1; nband = jmax - jlo + 1; ntiles = nband + 1; }
    const bf16_t *Qp, *Kp, *Vp, *K2p = nullptr; int ldq, ldk, ldv; bf16_t* Op;
    if (MODE == M_SB)       { Qp = proj + h * 64; ldq = NIN; Kp = proj + 512 + h * 64; ldk = NIN; Vp = proj + 1024 + h * 64; ldv = NIN; Op = proj + E_GATE + h * 64; }
    else if (MODE == M_MLA) { Qp = qm + h * 96; ldq = 768; Kp = kvb + h * 128; ldk = 1024; Vp = kvb + h * 128 + 64; ldv = 1024; K2p = proj + E_KR; Op = proj + E_GATE + 512 + h * 64; }
    else if (MODE == M_SWA) { Qp = proj + h * 64; ldq = NIN; Kp = proj + 512 + (h >> 2) * 64; ldk = NIN; Vp = proj + 640 + (h >> 2) * 64; ldv = NIN; Op = proj + O_GATE + h * 64; }
    else                    { Qp = proj + 768 + h * 64; ldq = NIN; Kp = proj + 1280 + h * 64; ldk = NIN; Vp = proj + 1792 + h * 64; ldv = NIN; Op = proj + O_GATE + 512 + h * 64; }

    LAS float* cb = (LAS float*)(lds + ATT_CB);
    if (MODE == M_FOX) {
        LAS float* utmp = (LAS float*)(lds + ATT_UTMP); LAS float* uo = (LAS float*)(lds + ATT_UOFF);
        const float* utot = (const float*)(wsa + OFF_UTOT) + (size_t)(b * 8 + h) * 256;
        const float* lcum = (const float*)(wsa + OFF_LCUM) + (size_t)(b * 8 + h) * LPAD;
        if (tid < NUNIT_SEQ) utmp[tid] = utot[tid];
        __syncthreads();
        if (tid < NUNIT_SEQ) { float a = 0.f; for (int i = 0; i < tid; ++i) a += utmp[i]; uo[tid] = a; }
        __syncthreads();
        const float base = uo[q0 >> 5];
        const int kend = (q0 + 256) < LPAD ? (q0 + 256) : LPAD;
        for (int s = tid; s < kend; s += 512) cb[s] = (lcum[s] + uo[s >> 5] - base) * LOG2E;
    }
    float slope2 = 0.f, sink2 = 0.f;
    if (MODE == M_SWA) { slope2 = exp2f(-(float)(h + 1)) * LOG2E; sink2 = P.sinks[li * 8 + h] * LOG2E; }

    bf16x8 qf[NKS];
#pragma unroll
    for (int ks = 0; ks < NKS; ++ks) {
        if (wave_on) qf[ks] = *(const bf16x8*)(Qp + (rowbase + qi) * ldq + ks * 16 + hi * 8);
        else qf[ks] = (bf16x8){0, 0, 0, 0, 0, 0, 0, 0};
    }
    f32x16 o[2];
#pragma unroll
    for (int r = 0; r < 16; ++r) { o[0][r] = 0.f; o[1][r] = 0.f; }
    float mrow = NEGB, lrow = 0.f, carry = 0.f;
    bool wdone = !wave_on;

    bf16x8 kreg0, kreg1, vreg;
    kreg1 = (bf16x8){0, 0, 0, 0, 0, 0, 0, 0};
#define TILE_OF(it) ((MODE == M_SWA) ? ((it) < nband ? jmax - (it) : 0) : jmax - (it))
#define GLOAD(j) do { const size_t r_ = rowbase + (size_t)64 * (j); \
        kreg0 = *(const bf16x8*)(Kp + (r_ + lane) * ldk + wid * 8); \
        if (MODE == M_MLA && wid < 4) kreg1 = *(const bf16x8*)(K2p + (r_ + lane) * NIN + wid * 8); \
        vreg = *(const bf16x8*)(Vp + (r_ + 16 * (wid & 3) + (lane >> 2)) * ldv + (wid >> 2) * 32 + (lane & 3) * 8); } while (0)
#define LWRITE(buf) do { LAS unsigned char* b_ = lds + (buf) * BUFB; \
        *(LAS bf16x8*)(b_ + wid * 1024 + lane * 16) = kreg0; \
        if (MODE == M_MLA && wid < 4) *(LAS bf16x8*)(b_ + (8 + wid) * 1024 + lane * 16) = kreg1; \
        *(LAS bf16x8*)(b_ + KBYTES + wid * 1024 + lane * 16) = vreg; } while (0)

    GLOAD(TILE_OF(0)); LWRITE(0);
    __syncthreads();
    const int vbase = KBYTES + (4 * hi + ((lane & 15) >> 2)) * 64 + ((lane >> 4) & 1) * 32 + (lane & 3) * 8;
    for (int it = 0; it < ntiles; ++it) {
        const int j = TILE_OF(it);
        if (it + 1 < ntiles) GLOAD(TILE_OF(it + 1));
        bool act = wave_on && !wdone && (j <= cw);
        if (MODE == M_SWA) act = act && (j == 0 || j >= cw - 2);
        if (act) {
            const LAS unsigned char* kb = lds + (it & 1) * BUFB;
            f32x16 s[2];
#pragma unroll
            for (int r = 0; r < 16; ++r) { s[0][r] = 0.f; s[1][r] = 0.f; }
#pragma unroll
            for (int ks = 0; ks < NKS; ++ks) {
                const bf16x8 k0 = *(const LAS bf16x8*)(kb + (2 * ks + hi) * 1024 + r32 * 16);
                const bf16x8 k1 = *(const LAS bf16x8*)(kb + (2 * ks + hi) * 1024 + (32 + r32) * 16);
                s[0] = MFMA32(k0, qf[ks], s[0]); s[1] = MFMA32(k1, qf[ks], s[1]);
            }
            const int key0 = 64 * j + 4 * hi;
            if (MODE == M_SB) {
                float tl[8], tp[8], ab[8];
                f32x16 lsv[2];
#pragma unroll
                for (int n = 0; n < 2; ++n)
#pragma unroll
                    for (int g = 0; g < 4; ++g) {
                        float tsum = 0.f;
#pragma unroll
                        for (int i = 0; i < 4; ++i) {
                            const int reg = 4 * g + i, key = key0 + 32 * n + 8 * g + i;
                            const bool valid = (key < qi) && (key >= POFF);
                            const float z = s[n][reg];
                            const float e = __expf(-fabsf(z));
                            const float sp = fmaxf(z, 0.f) + __logf(1.f + e);
                            const float l = valid ? -sp : 0.f;
                            lsv[n][reg] = l; tsum += l;
                            s[n][reg] = valid ? (z - sp) : NEGB;
                        }
                        tl[4 * n + g] = tsum;
                    }
#pragma unroll
                for (int c = 0; c < 8; ++c) tp[c] = shx(tl[c], 32, lane);
                float accs = 0.f;
#pragma unroll
                for (int c = 7; c >= 0; --c) { ab[c] = accs + (hi == 0 ? tp[c] : 0.f); accs += tl[c] + tp[c]; }
#pragma unroll
                for (int n = 0; n < 2; ++n)
#pragma unroll
                    for (int g = 0; g < 4; ++g) {
                        float a = carry + ab[4 * n + g];
#pragma unroll
                        for (int i = 3; i >= 0; --i) {
                            const int reg = 4 * g + i;
                            const float w = __expf(s[n][reg] + a);
                            a += lsv[n][reg];
                            s[n][reg] = w;
                        }
                    }
                carry += accs;
            } else {
                if (MODE == M_FOX) {
#pragma unroll
                    for (int n = 0; n < 2; ++n)
#pragma unroll
                        for (int g = 0; g < 4; ++g) { const f32x4 c4 = *(const LAS f32x4*)(cb + key0 + 32 * n + 8 * g);
#pragma unroll
                            for (int i = 0; i < 4; ++i) s[n][4 * g + i] -= c4[i]; }
                }
                if (MODE == M_SWA) {
#pragma unroll
                    for (int n = 0; n < 2; ++n)
#pragma unroll
                        for (int r = 0; r < 16; ++r) { const int key = key0 + 32 * n + 8 * (r >> 2) + (r & 3); s[n][r] -= slope2 * fabsf((float)(qi - key)); }
                }
                if (j == 0) {
#pragma unroll
                    for (int n = 0; n < 2; ++n)
#pragma unroll
                        for (int r = 0; r < 16; ++r) { const int key = key0 + 32 * n + 8 * (r >> 2) + (r & 3); if (key < POFF) s[n][r] = NEGB; }
                }
                if (MODE == M_FOX && j == cw) {
#pragma unroll
                    for (int n = 0; n < 2; ++n)
#pragma unroll
                        for (int r = 0; r < 16; ++r) { const int key = key0 + 32 * n + 8 * (r >> 2) + (r & 3); if (key > qi) s[n][r] = NEGB; }
                }
                float mx = s[0][0];
#pragma unroll
                for (int r = 1; r < 16; ++r) mx = fmaxf(mx, s[0][r]);
#pragma unroll
                for (int r = 0; r < 16; ++r) mx = fmaxf(mx, s[1][r]);
                mx = fmaxf(mx, shx(mx, 32, lane));
                const float mnew = fmaxf(mrow, mx);
                const float alpha = __builtin_amdgcn_exp2f(mrow - mnew);
                mrow = mnew;
                float psum = 0.f;
#pragma unroll
                for (int n = 0; n < 2; ++n)
#pragma unroll
                    for (int r = 0; r < 16; ++r) { const float pv = __builtin_amdgcn_exp2f(s[n][r] - mnew); s[n][r] = pv; psum += pv; }
                lrow = lrow * alpha + psum;
#pragma unroll
                for (int r = 0; r < 16; ++r) { o[0][r] *= alpha; o[1][r] *= alpha; }
            }
#pragma unroll
            for (int n = 0; n < 2; ++n)
#pragma unroll
                for (int sp = 0; sp < 2; ++sp) {
                    u32x4 pw; pw.x = cvtpk(s[n][8 * sp + 0], s[n][8 * sp + 1]); pw.y = cvtpk(s[n][8 * sp + 2], s[n][8 * sp + 3]);
                    pw.z = cvtpk(s[n][8 * sp + 4], s[n][8 * sp + 5]); pw.w = cvtpk(s[n][8 * sp + 6], s[n][8 * sp + 7]);
                    const bf16x8 pb = __builtin_bit_cast(bf16x8, pw);
#pragma unroll
                    for (int db = 0; db < 2; ++db) {
                        const LAS unsigned char* vp = kb + vbase + db * 4096 + (32 * n + 16 * sp) * 64;
                        const s16x4 vlo = vtr(vp), vhi = vtr(vp + 8 * 64);
                        const bf16x8 va = (bf16x8){vlo[0], vlo[1], vlo[2], vlo[3], vhi[0], vhi[1], vhi[2], vhi[3]};
                        o[db] = MFMA32(va, pb, o[db]);
                    }
                }
        }
        if (MODE == M_SB) {
            const bool dn = !wave_on || (__builtin_amdgcn_ballot_w64(carry < -120.f) == ~0ull);
            wdone = dn;
            if (lane == 0) ((LAS unsigned*)(lds + ATT_FLAGS))[(it & 1) * 8 + wid] = dn ? 1u : 0u;
        }
        if (it + 1 < ntiles) LWRITE((it + 1) & 1);
        __syncthreads();
        if (MODE == M_SB) {
            const LAS unsigned* fl = (const LAS unsigned*)(lds + ATT_FLAGS) + (it & 1) * 8;
            const unsigned all = fl[0] & fl[1] & fl[2] & fl[3] & fl[4] & fl[5] & fl[6] & fl[7];
            if (all) break;
        }
    }
    __syncthreads();
    if (wave_on) {
        float inv = 1.f;
        if (MODE != M_SB) { float lt = lrow + shx(lrow, 32, lane); if (MODE == M_SWA) lt += __builtin_amdgcn_exp2f(sink2 - mrow); inv = 1.f / lt; }
        bf16_t* orow = Op + (rowbase + qi) * NIN;
#pragma unroll
        for (int db = 0; db < 2; ++db)
#pragma unroll
            for (int g = 0; g < 4; ++g) {
                bf16_t* p = orow + 32 * db + 8 * g + 4 * hi;
                const u32x2 gw = *(const u32x2*)p;
                const float g0 = __uint_as_float(gw.x << 16), g1 = __uint_as_float(gw.x & 0xffff0000u), g2 = __uint_as_float(gw.y << 16), g3 = __uint_as_float(gw.y & 0xffff0000u);
                f32x4 v = (f32x4){o[db][4 * g + 0] * inv * g0, o[db][4 * g + 1] * inv * g1, o[db][4 * g + 2] * inv * g2, o[db][4 * g + 3] * inv * g3};
                if (!dry) store4bf(p, v);
            }
    }
#undef TILE_OF
#undef GLOAD
#undef LWRITE
}

template <class CM>
__device__ __forceinline__ void convert_T(LAS unsigned char* lds, const float* src, int lds_src, bf16_t* dst, int K, int Nd, const float* kscale, CM cm) {
    LAS float* tile = (LAS float*)lds;
    const int tid = threadIdx.x, tk = K / 64, tn = Nd / 64;
    for (int t = blockIdx.x; t < tk * tn; t += gridDim.x) {
        const int k0 = (t % tk) * 64, n0 = (t / tk) * 64;
#pragma unroll
        for (int i = 0; i < 8; ++i) {
            const int kk = i * 8 + (tid >> 6), nn = tid & 63; const int sc = cm(n0 + nn);
            float v = sc >= 0 ? src[(size_t)(k0 + kk) * lds_src + sc] : 0.f;
            if (kscale) v *= kscale[k0 + kk];
            tile[kk * 65 + nn] = v;
        }
        __syncthreads();
        { const int nn = tid >> 3, kc = (tid & 7) * 8; u32x4 w;
          w.x = cvtpk(tile[(kc + 0) * 65 + nn], tile[(kc + 1) * 65 + nn]); w.y = cvtpk(tile[(kc + 2) * 65 + nn], tile[(kc + 3) * 65 + nn]);
          w.z = cvtpk(tile[(kc + 4) * 65 + nn], tile[(kc + 5) * 65 + nn]); w.w = cvtpk(tile[(kc + 6) * 65 + nn], tile[(kc + 7) * 65 + nn]);
          *(u32x4*)(dst + (size_t)(n0 + nn) * K + k0 + kc) = w; }
        __syncthreads();
    }
}
struct CmIdent { __device__ __forceinline__ int operator()(int n) const { return n; } };
struct CmEvenIn { __device__ __forceinline__ int operator()(int n) const { if (n < 2048) return n; if (n < 3072) return n + 32; if (n < 3104) { const int rc = n - 3072; return 2048 + (rc >> 1) + 16 * (rc & 1); } return -1; } };
struct CmOddIn { __device__ __forceinline__ int operator()(int n) const { return n < 2304 ? n : n + 8; } };
struct CmUq { __device__ __forceinline__ int operator()(int n) const { const int hh = n / 96, c = n % 96; if (c < 64) return n; const int rc = c - 64; return hh * 96 + 64 + (rc >> 1) + 16 * (rc & 1); } };

__device__ __forceinline__ void prep_phase(const Params& P, LAS unsigned char* lds) {
    unsigned char* ws = P.ws;
    for (int i = 0; i < 2; ++i) {
        convert_T(lds, P.w_in_even + (size_t)i * DM * SRC_EVEN_IN, SRC_EVEN_IN, (bf16_t*)(ws + OFF_WINE + i * SZ_WIN), DM, NIN, nullptr, CmEvenIn());
        convert_T(lds, P.w_in_odd + (size_t)i * DM * SRC_ODD_IN, SRC_ODD_IN, (bf16_t*)(ws + OFF_WINO + i * SZ_WIN), DM, NIN, nullptr, CmOddIn());
        convert_T(lds, P.w_out_even + (size_t)i * DM * DM, DM, (bf16_t*)(ws + OFF_WOUTE + i * SZ_WOUT), DM, DM, nullptr, CmIdent());
        convert_T(lds, P.w_out_odd + (size_t)i * DM * DM, DM, (bf16_t*)(ws + OFF_WOUTO + i * SZ_WOUT), DM, DM, nullptr, CmIdent());
        convert_T(lds, P.w_uq + (size_t)i * 256 * 768, 768, (bf16_t*)(ws + OFF_WUQ + i * SZ_WUQ), 256, 768, P.g_cq + i * 256, CmUq());
        convert_T(lds, P.w_ukv + (size_t)i * 256 * 1024, 1024, (bf16_t*)(ws + OFF_WUKV + i * SZ_WUKV), 256, 1024, P.g_ckv + i * 256, CmIdent());
    }
    const size_t gtid = (size_t)blockIdx.x * 512 + threadIdx.x, gn = (size_t)gridDim.x * 512;
    bf16_t* HB = (bf16_t*)(ws + OFF_HB);
#pragma unroll 4
    for (size_t idx = gtid; idx < (size_t)T * 256; idx += gn) {
        const int row = (int)(idx >> 8), c4 = (int)(idx & 255), b = row / LPAD, pp = row % LPAD;
        f32x4 v = (f32x4){0.f, 0.f, 0.f, 0.f};
        if (pp >= 64) v = __builtin_nontemporal_load((const f32x4*)(P.x + ((size_t)(b * SEQ + pp - 64)) * DM + c4 * 4));
        else if (pp >= POFF) v = *(const f32x4*)(P.meta + (size_t)(pp - POFF) * DM + c4 * 4);
        store4bf(HB + (size_t)row * DM + c4 * 4, v);
    }
    float2* rope = (float2*)(ws + OFF_ROPE);
    for (size_t idx = gtid; idx < (size_t)LPAD * 16; idx += gn) {
        const int pp = (int)(idx >> 4), i = (int)(idx & 15); const int pos = pp >= POFF ? pp - POFF : 0;
        const float inv = powf(10000.0f, -(float)i / 16.0f); const float ang = (float)pos * inv;
        float sn, cs; sincosf(ang, &sn, &cs); rope[idx] = make_float2(cs, sn);
    }
    float* ssq = (float*)(ws + OFF_SSQ);
    for (size_t idx = gtid; idx < (size_t)4 * T; idx += gn) ssq[idx] = 0.f;
}

__device__ __forceinline__ void ln_phase(const Params& P, LAS unsigned char* lds, int layer, bool fz, int fi, bool last, bool dry = false) {
    int tid = threadIdx.x; asm volatile("" : "+v"(tid));
    const int lane = tid & 63, wid = tid >> 6;
    unsigned char* ws = P.ws; asm volatile("" : "+s"(ws));
    float* H = (float*)(ws + OFF_H); bf16_t* HB = (bf16_t*)(ws + OFF_HB);
    LAS float* wfz = (LAS float*)lds;
    LAS float* lc = (LAS float*)(lds + 32768);
    LAS float* wt = (LAS float*)(lds + 32768 + 1024);
    if (fz) {
        const float* src = P.w_in_odd + (size_t)fi * DM * SRC_ODD_IN + 2304;
        for (int e = tid; e < 8192; e += 512) wfz[e] = src[(size_t)(e >> 3) * SRC_ODD_IN + (e & 7)];
        __syncthreads();
    }
    const float* gain = P.ln_gain + layer * DM; const float* bias = P.ln_bias + layer * DM;
    f32x4 gv[4], bv[4];
#pragma unroll
    for (int i = 0; i < 4; ++i) { gv[i] = *(const f32x4*)(gain + 4 * lane + 256 * i); bv[i] = *(const f32x4*)(bias + 4 * lane + 256 * i); }
    const int myhd = ((lane & 1) << 2) | (lane & 2) | ((lane >> 2) & 1);
    const float bfg = fz ? P.b_forget[fi * 8 + myhd] : 0.f;
    for (int unit = blockIdx.x; unit < T / 32; unit += gridDim.x) {
        const int row0 = unit * 32 + wid * 4;
        f32x4 v[4][4];
#pragma unroll
        for (int rr = 0; rr < 4; ++rr)
#pragma unroll
            for (int i = 0; i < 4; ++i) v[rr][i] = *(const f32x4*)(H + (size_t)(row0 + rr) * DM + 4 * lane + 256 * i);
        float s[4], q[4];
#pragma unroll
        for (int rr = 0; rr < 4; ++rr) { s[rr] = 0.f;
#pragma unroll
            for (int i = 0; i < 4; ++i) s[rr] += (v[rr][i][0] + v[rr][i][1]) + (v[rr][i][2] + v[rr][i][3]); }
#pragma unroll
        for (int o = 1; o < 64; o <<= 1)
#pragma unroll
            for (int rr = 0; rr < 4; ++rr) s[rr] += shx(s[rr], o, lane);
#pragma unroll
        for (int rr = 0; rr < 4; ++rr) { const float mu = s[rr] * (1.0f / 1024.0f); q[rr] = 0.f;
#pragma unroll
            for (int i = 0; i < 4; ++i) { v[rr][i] = v[rr][i] - mu; q[rr] += (v[rr][i][0] * v[rr][i][0] + v[rr][i][1] * v[rr][i][1]) + (v[rr][i][2] * v[rr][i][2] + v[rr][i][3] * v[rr][i][3]); } }
#pragma unroll
        for (int o = 1; o < 64; o <<= 1)
#pragma unroll
            for (int rr = 0; rr < 4; ++rr) q[rr] += shx(q[rr], o, lane);
#pragma unroll
        for (int rr = 0; rr < 4; ++rr) {
            const float rstd = 1.0f / sqrtf(q[rr] * (1.0f / 1024.0f) + 1e-5f);
#pragma unroll
            for (int i = 0; i < 4; ++i) v[rr][i] = v[rr][i] * rstd * gv[i] + bv[i];
            const int row = row0 + rr, b = row / LPAD, pp = row % LPAD;
            if (dry) { if (v[rr][0][0] == 123.456f) H[0] = 0.f; }
            else if (last) {
                if (pp >= 64) { float* op = P.out + ((size_t)(b * SEQ + pp - 64)) * DM;
#pragma unroll
                    for (int i = 0; i < 4; ++i) *(f32x4*)(op + 4 * lane + 256 * i) = v[rr][i]; }
            } else {
#pragma unroll
                for (int i = 0; i < 4; ++i) { *(f32x4*)(H + (size_t)row * DM + 4 * lane + 256 * i) = v[rr][i]; store4bf(HB + (size_t)row * DM + 4 * lane + 256 * i, v[rr][i]); }
            }
        }
        if (fz) {
            float run = 0.f;
#pragma unroll
            for (int rr = 0; rr < 4; ++rr) {
                float d[8];
#pragma unroll
                for (int hd = 0; hd < 8; ++hd) d[hd] = 0.f;
#pragma unroll
                for (int i = 0; i < 4; ++i)
#pragma unroll
                    for (int e = 0; e < 4; ++e) {
                        const LAS float* wp = wfz + (4 * lane + 256 * i + e) * 8; const f32x4 w0 = *(const LAS f32x4*)wp, w1 = *(const LAS f32x4*)(wp + 4);
                        const float y = v[rr][i][e];
                        d[0] += y * w0[0]; d[1] += y * w0[1]; d[2] += y * w0[2]; d[3] += y * w0[3]; d[4] += y * w1[0]; d[5] += y * w1[1]; d[6] += y * w1[2]; d[7] += y * w1[3];
                    }
                float e4[4], f2[2], g1;
#pragma unroll
                for (int k = 0; k < 4; ++k) { const float mine = (lane & 1) ? d[4 + k] : d[k], send = (lane & 1) ? d[k] : d[4 + k]; e4[k] = mine + shx(send, 1, lane); }
#pragma unroll
                for (int k = 0; k < 2; ++k) { const float mine = (lane & 2) ? e4[2 + k] : e4[k], send = (lane & 2) ? e4[k] : e4[2 + k]; f2[k] = mine + shx(send, 2, lane); }
                { const float mine = (lane & 4) ? f2[1] : f2[0], send = (lane & 4) ? f2[0] : f2[1]; g1 = mine + shx(send, 4, lane); }
                g1 += shx(g1, 8, lane); g1 += shx(g1, 16, lane); g1 += shx(g1, 32, lane);
                const float xx = g1 + bfg;
                const float lf = fminf(xx, 0.f) - log1pf(expf(-fabsf(xx)));
                run += lf;
                if (lane < 8) lc[(wid * 4 + rr) * 8 + myhd] = run;
            }
            if (lane < 8) wt[wid * 8 + myhd] = run;
            __syncthreads();
            const int b = (unit * 32) / LPAD, pp0 = (unit * 32) % LPAD;
            if (tid < 256 && !dry) {
                const int r = tid >> 3, hd = tid & 7, w = r >> 2; float off = 0.f;
                for (int w2 = 0; w2 < w; ++w2) off += wt[w2 * 8 + hd];
                ((float*)(ws + OFF_LCUM))[(size_t)(b * 8 + hd) * LPAD + pp0 + r] = lc[r * 8 + hd] + off;
            }
            if (tid < 8 && !dry) { float tt = 0.f; for (int w2 = 0; w2 < 8; ++w2) tt += wt[w2 * 8 + tid]; ((float*)(ws + OFF_UTOT))[(size_t)(b * 8 + tid) * 256 + (pp0 >> 5)] = tt; }
            __syncthreads();
        }
    }
}

__global__ void __launch_bounds__(512) fwd_megakernel(Params P) {
    extern __shared__ __attribute__((aligned(16))) unsigned char lds_raw[];
    LAS unsigned char* lds = (LAS unsigned char*)lds_raw;
    cg::grid_group grid = cg::this_grid();
    unsigned char* ws = P.ws;
    const int G = gridDim.x, bid = blockIdx.x;
    bf16_t* proj = (bf16_t*)(ws + OFF_PROJ);
    const float2* rope = (const float2*)(ws + OFF_ROPE);

    volatile LAS unsigned* xst = (volatile LAS unsigned*)(lds + 131072);
    if (threadIdx.x == 0) { xst[0] = 0u; xst[1] = 0u; xst[2] = 0u; xst[3] = 0u; }
    __syncthreads();
    XcdBarrier xbar = xcd_barrier_post((unsigned*)(ws + OFF_BAR), xst);
    for (int rep = 0; rep < REP_PREP; ++rep) { prep_phase(P, lds); if (rep + 1 < REP_PREP) grid.sync(); }
    grid.sync();
#define GSYNC() xcd_barrier(xbar)

    for (int layer = 0; layer < 4; ++layer) {
        const int li = layer >> 1; const bool even = (layer & 1) == 0;
        for (int rep = 0; rep < REP_GEMM; ++rep) {
            TileOrder ord; ord.init(NMT, 13);
            for (int i = 0;; ++i) {
                int pm, pn; if (!ord.get(i * G + bid, pm, pn)) break;
                gemm_unit(lds, ws, even ? GK_IN_EVEN : GK_IN_ODD, li, pm, pn, rep + 1 < REP_GEMM);
            }
            if (rep + 1 < REP_GEMM) GSYNC();
        }
        GSYNC();
        if (even) {
            for (int rep = 0; rep < REP_GEMM; ++rep) {
            for (int u = bid; u < NMT * 7; u += G) {
                int kind, pm, pn;
                if (u < NMT * 3) { kind = GK_UPQ; pm = u / 3; pn = u % 3; } else { const int u2 = u - NMT * 3; kind = GK_UPKV; pm = u2 / 4; pn = u2 % 4; }
                gemm_unit(lds, ws, kind, li, pm, pn);
            }
            if (rep + 1 < REP_GEMM) GSYNC();
            }
            GSYNC();
        }
        for (int rep = 0; rep < REP_ATTN; ++rep) {
        const bool dry = rep + 1 < REP_ATTN;
        for (int r = 0; r * G < 2176; ++r) {
            const int s = r * G + ((r & 1) ? (G - 1 - bid) : bid);
            if (s >= 2176) continue;
            const bool heavy = s < 1088; const int idx = heavy ? s : s - 1088;
            const int qt = 16 - idx / 64, bh = idx % 64, b = bh >> 3, h = bh & 7;
            if (even) { if (heavy) attn_unit<M_MLA>(P, lds, li, b, h, qt, dry); else attn_unit<M_SB>(P, lds, li, b, h, qt, dry); }
            else      { if (heavy) attn_unit<M_FOX>(P, lds, li, b, h, qt, dry); else attn_unit<M_SWA>(P, lds, li, b, h, qt, dry); }
        }
        GSYNC();
        }
        for (int rep = 0; rep < REP_GEMM; ++rep) {
            TileOrder ord; ord.init(NMT, 4);
            for (int i = 0;; ++i) { int pm, pn; if (!ord.get(i * G + bid, pm, pn)) break;
                gemm_unit(lds, ws, even ? GK_OUT_EVEN : GK_OUT_ODD, li, pm, pn, rep + 1 < REP_GEMM, layer == 0 ? P.x : nullptr, layer == 0 ? P.meta : nullptr);
            }
            GSYNC();
        }
        for (int rep = 0; rep < REP_LN; ++rep) {
            ln_phase(P, lds, layer,  even,  li,  layer == 3, rep + 1 < REP_LN);
            if (rep + 1 < REP_LN) GSYNC();
        }
        if (layer < 3) GSYNC();
    }
}

extern "C" void kernel_launch(void* const* d_in, const int* in_sizes, int n_in, void* d_out, int out_size, void* d_ws, size_t ws_size, hipStream_t stream) {
    constexpr size_t kDynLds = 131072 + 16;
    static int grid_blocks = 0;
    if (!grid_blocks) {
        int dev = 0, cus = 0, per_cu = 0;
        hipGetDevice(&dev);
        hipDeviceGetAttribute(&cus, hipDeviceAttributeMultiprocessorCount, dev);
        hipFuncSetAttribute((const void*)fwd_megakernel, hipFuncAttributeMaxDynamicSharedMemorySize, (int)kDynLds);
        hipOccupancyMaxActiveBlocksPerMultiprocessor(&per_cu, (const void*)fwd_megakernel, 512, kDynLds);
        if (per_cu < 1) per_cu = 1;
        if (per_cu > 1) per_cu = 1;
        grid_blocks = cus * per_cu;
        if (ws_size < WS_END) fprintf(stderr, "kernel_launch: workspace too small: %zu < %zu\n", ws_size, (size_t)WS_END);
    }
    Params p{};
    p.x = (const float*)d_in[0]; p.meta = (const float*)d_in[1]; p.w_in_even = (const float*)d_in[2]; p.g_cq = (const float*)d_in[3]; p.g_ckv = (const float*)d_in[4];
    p.w_uq = (const float*)d_in[5]; p.w_ukv = (const float*)d_in[6]; p.w_out_even = (const float*)d_in[7]; p.w_in_odd = (const float*)d_in[8]; p.b_forget = (const float*)d_in[9];
    p.sinks = (const float*)d_in[10]; p.w_out_odd = (const float*)d_in[11]; p.ln_gain = (const float*)d_in[12]; p.ln_bias = (const float*)d_in[13];
    p.out = (float*)d_out; p.ws = (unsigned char*)d_ws;
    (void)hipMemsetAsync((unsigned char*)d_ws + OFF_BAR, 0, SZ_BAR, stream);
    void* args[] = {&p};
    hipError_t e = hipLaunchCooperativeKernel((const void*)fwd_megakernel, dim3(grid_blocks), dim3(512), args, kDynLds, stream);
    if (e != hipSuccess) fprintf(stderr, "cooperative launch failed: %s (grid %d)\n", hipGetErrorString(e), grid_blocks);
}
```

```cpp
#include <hip/hip_runtime.h>
#include <hip/hip_cooperative_groups.h>
#include <cstdio>
#include <cstdint>
namespace cg = cooperative_groups;
#ifndef REP_GEMM
#define REP_GEMM 1
#endif
#ifndef REP_ATTN
#define REP_ATTN 1
#endif
#ifndef REP_LN
#define REP_LN 1
#endif
#ifndef REP_PREP
#define REP_PREP 1
#endif

#define LAS __attribute__((address_space(3)))
#define GAS __attribute__((address_space(1)))
typedef unsigned short bf16_t;
typedef short bf16x8 __attribute__((ext_vector_type(8)));
typedef short s16x4 __attribute__((ext_vector_type(4)));
typedef float f32x4 __attribute__((ext_vector_type(4)));
typedef float f32x2 __attribute__((ext_vector_type(2)));
typedef float f32x16 __attribute__((ext_vector_type(16)));
typedef unsigned u32x2 __attribute__((ext_vector_type(2)));
typedef unsigned u32x4 __attribute__((ext_vector_type(4)));

constexpr int DM = 1024, NB = 8, SEQ = 4096, NMETA = 16;
constexpr int POFF = 48;
constexpr int LPAD = 4160;
constexpr int T = NB * LPAD;
constexpr int NMT = T / 256;
constexpr int NIN = 3328;
constexpr int SRC_EVEN_IN = 3104, SRC_ODD_IN = 3336;
constexpr int NUNIT_SEQ = LPAD / 32;
constexpr float LOG2E = 1.4426950408889634f;
constexpr float DN_ALPHA = 1.681792830507429f;
constexpr float NEGB = -1e30f;

constexpr int E_GATE = 2048, E_KR = 3072, O_GATE = 2304;

constexpr size_t SZ_H = (size_t)T * DM * 4, SZ_HB = (size_t)T * DM * 2, SZ_PROJ = (size_t)T * NIN * 2, SZ_QM = (size_t)T * 768 * 2;
constexpr size_t OFF_H = 0, OFF_HB = OFF_H + SZ_H, OFF_PROJ = OFF_HB + SZ_HB, OFF_QM = OFF_PROJ + SZ_PROJ, OFF_W = OFF_QM + SZ_QM;
constexpr size_t SZ_WIN = (size_t)NIN * DM * 2, SZ_WUQ = 768 * 256 * 2, SZ_WUKV = 1024 * 256 * 2, SZ_WOUT = (size_t)DM * DM * 2;
constexpr size_t OFF_WINE = OFF_W, OFF_WUQ = OFF_WINE + 2 * SZ_WIN, OFF_WUKV = OFF_WUQ + 2 * SZ_WUQ, OFF_WOUTE = OFF_WUKV + 2 * SZ_WUKV,
                 OFF_WINO = OFF_WOUTE + 2 * SZ_WOUT, OFF_WOUTO = OFF_WINO + 2 * SZ_WIN, OFF_SSQ = OFF_WOUTO + 2 * SZ_WOUT;
constexpr size_t SZ_SSQ = (size_t)4 * T * 4;
constexpr size_t OFF_LCUM = OFF_SSQ + SZ_SSQ, SZ_LCUM = (size_t)NB * 8 * LPAD * 4;
constexpr size_t OFF_UTOT = OFF_LCUM + SZ_LCUM, SZ_UTOT = (size_t)NB * 8 * 256 * 4;
constexpr size_t OFF_ROPE = OFF_UTOT + SZ_UTOT, SZ_ROPE = (size_t)LPAD * 16 * 8;
constexpr size_t OFF_BAR = OFF_ROPE + SZ_ROPE, SZ_BAR = 16384;
constexpr size_t WS_END = OFF_BAR + SZ_BAR;

struct Params {
    const float *x, *meta, *w_in_even, *g_cq, *g_ckv, *w_uq, *w_ukv, *w_out_even, *w_in_odd, *b_forget, *sinks, *w_out_odd, *ln_gain, *ln_bias;
    float* out; unsigned char* ws;
};

__device__ __forceinline__ unsigned cvtpk(float lo, float hi) { unsigned r; asm volatile("v_cvt_pk_bf16_f32 %0, %1, %2" : "=v"(r) : "v"(lo), "v"(hi)); return r; }
__device__ __forceinline__ float shx(float v, int mask, int lane) { return __int_as_float(__builtin_amdgcn_ds_bpermute((lane ^ mask) << 2, __float_as_int(v))); }
__device__ __forceinline__ int crow(int r, int hi) { return (r & 3) + 8 * (r >> 2) + 4 * hi; }
__device__ __forceinline__ float silu_f(float x) { return x / (1.f + __expf(-x)); }
__device__ __forceinline__ void store4bf(bf16_t* p, f32x4 v) { u32x2 w; w.x = cvtpk(v[0], v[1]); w.y = cvtpk(v[2], v[3]); *(GAS u32x2*)p = w; }


#define XB_TMO      128
#define XB_XCNT(j)  (256  + 64 * (j))
#define XB_XSUB(j)  (1280 + 64 * (j))
#define XB_XGEN(j)  (2304 + 64 * (j))
#define XB_TOP      3328
#define XB_TOPGEN   3392
#define XCD_BAR_WORDS 3456
#define XB_SPIN_CAP (1u << 18)
__device__ __forceinline__ unsigned xb_ld(unsigned* p)              { return __hip_atomic_load(p, __ATOMIC_RELAXED, __HIP_MEMORY_SCOPE_AGENT); }
__device__ __forceinline__ unsigned xb_add(unsigned* p, unsigned v) { return __hip_atomic_fetch_add(p, v, __ATOMIC_RELAXED, __HIP_MEMORY_SCOPE_AGENT); }
__device__ __forceinline__ unsigned xb_xcc_id() { return (unsigned)__builtin_amdgcn_s_getreg((3 << 11) | 20) & 0xFu; }
#define XB_SPIN(cond, bar) do { unsigned _sp = 0; while (cond) { __builtin_amdgcn_s_sleep(1); \
    if ((++_sp & 255u) == 0u) { if (xb_ld(&(bar)[XB_TMO])) break; if (_sp > XB_SPIN_CAP) { atomicAdd(&(bar)[XB_TMO], 1u); break; } } } } while (0)
struct XcdBarrier { unsigned* bar; unsigned x; volatile LAS unsigned* st; };
__device__ __forceinline__ XcdBarrier xcd_barrier_post(unsigned* bar, volatile LAS unsigned* st) {
    XcdBarrier b; b.bar = bar; b.x = xb_xcc_id(); b.st = st;
    if (threadIdx.x == 0) (void)xb_add(&bar[XB_XCNT(b.x)], 1u);
    return b;
}
__device__ __forceinline__ void xcd_barrier_complete(unsigned* bar, unsigned x, unsigned& nloc, unsigned& nx) {
    const unsigned G = gridDim.x * gridDim.y * gridDim.z;
    unsigned sum, cnt, mine, sp = 0u;
    for (;;) {
        sum = 0u; cnt = 0u; mine = 0u;
#pragma unroll
        for (unsigned j = 0; j < 16; ++j) { const unsigned c = xb_ld(&bar[XB_XCNT(j)]); sum += c; cnt += (c > 0u) ? 1u : 0u; mine = (j == x) ? c : mine; }
        if (sum == G) break;
        __builtin_amdgcn_s_sleep(1);
        if ((++sp & 255u) == 0u) { if (xb_ld(&bar[XB_TMO])) break; if (sp > XB_SPIN_CAP) { atomicAdd(&bar[XB_TMO], 1u); break; } }
    }
    nloc = mine > 0u ? mine : 1u; nx = cnt > 0u ? cnt : 1u;
}
__device__ __forceinline__ void xcd_barrier(const XcdBarrier& b) {
    asm volatile("s_waitcnt vmcnt(0)" ::: "memory");
    __syncthreads();
    if (threadIdx.x == 0) {
        unsigned* bar = b.bar;
        __builtin_amdgcn_s_waitcnt(0);
        unsigned nloc = b.st[0], nx = b.st[1];
        if (nloc == 0u) { xcd_barrier_complete(bar, b.x, nloc, nx); b.st[0] = nloc; b.st[1] = nx; }
        const unsigned old = xb_add(&bar[XB_XSUB(b.x)], 1u);
        const unsigned gen = old / nloc;
        if (old + 1u == (gen + 1u) * nloc) {
            __builtin_amdgcn_fence(__ATOMIC_RELEASE, "agent");
            asm volatile("s_waitcnt vmcnt(0)" ::: "memory");
            const unsigned og = xb_add(&bar[XB_TOP], 1u);
            const unsigned tg = og / nx;
            if (og + 1u == (tg + 1u) * nx) xb_add(&bar[XB_TOPGEN], 1u);
            else XB_SPIN(xb_ld(&bar[XB_TOPGEN]) == tg, bar);
            __builtin_amdgcn_fence(__ATOMIC_ACQUIRE, "agent");
            xb_add(&bar[XB_XGEN(b.x)], 1u);
            asm volatile("s_waitcnt vmcnt(0)" ::: "memory");
        } else {
            XB_SPIN(xb_ld(&bar[XB_XGEN(b.x)]) == gen, bar);
            __builtin_amdgcn_fence(__ATOMIC_ACQUIRE, "agent");
            asm volatile("s_waitcnt vmcnt(0)" ::: "memory");
        }
    }
    __syncthreads();
}

constexpr int HTB = 128 * 64 * 2;
__device__ __forceinline__ int lds_byte(int r, int c) { const int st = (r >> 4) * 2 + (c >> 5), rr = r & 15, cc = c & 31, ob = rr * 64 + cc * 2; return st * 1024 + (ob ^ (((ob >> 9) & 1) << 5)); }
__device__ __forceinline__ void stage_rc(int b, int& R, int& C) { const int st = b / 1024, sb = b % 1024, swz = sb ^ (((sb >> 9) & 1) << 5); R = (st >> 1) * 16 + swz / 64; C = (st & 1) * 32 + (swz % 64) / 2; }

enum { TR_NONE = 0, TR_SCALE, TR_SILU, TR_SSQ, TR_ROPEKR, TR_UPQ, TR_UPKV, TR_OUT };
struct Epi { int tr; float fac; bf16_t* dst; int ldd; float* aux; const float2* rope; };

struct TileOrder {
    int nM, nN, nwg;
    __device__ __forceinline__ void init(int nM_, int nN_) { nM = nM_; nN = nN_; nwg = nM * nN; }
    __device__ __forceinline__ bool get(int L, int& pm, int& pn) const {
        if (L >= nwg) return false;
        int wgid = L; { const int q = nwg / 8, r = nwg % 8, xcd = wgid % 8, off = wgid / 8; wgid = (xcd < r ? xcd * (q + 1) : r * (q + 1) + (xcd - r) * q) + off; }
        const int nig = 8 * nN, gid = wgid / nig, fm = gid * 8, gsz = (nM - fm) < 8 ? (nM - fm) : 8;
        pm = fm + ((wgid % nig) % gsz); pn = (wgid % nig) / gsz; return true;
    }
};

#define G_SA(b, h) (((b) * 2 + (h)) * HTB)
#define G_SB(b, h) ((4 + (b) * 2 + (h)) * HTB)
#define G_STAGE(bufoff, gbase, voff, qstep) do { _Pragma("unroll") for (int _i = 0; _i < 2; ++_i) \
    __builtin_amdgcn_global_load_lds((const unsigned*)((const char*)(gbase) + (size_t)_i * (qstep) + (voff)), (LAS unsigned*)(lds + (bufoff) + ldsw + _i * 8192), 16, 0, 0); } while (0)
#define G_STA(b, h, kt) G_STAGE(G_SA(b, h), Ab + (size_t)(h) * hstepA + (size_t)(kt) * 128, voffA, qstepA)
#define G_STB(b, h, kt) G_STAGE(G_SB(b, h), Bb + (size_t)(h) * hstepB + (size_t)(kt) * 128, voffB, qstepB)
#define G_LDA(dst, b, h) do { _Pragma("unroll") for (int m = 0; m < 4; ++m) _Pragma("unroll") for (int k = 0; k < 2; ++k) dst[m][k] = *(const LAS bf16x8*)(lds + G_SA(b, h) + aoff + m * 2048 + k * 1024); } while (0)
#define G_LDB(dst, b, h) do { _Pragma("unroll") for (int n = 0; n < 2; ++n) _Pragma("unroll") for (int k = 0; k < 2; ++k) dst[n][k] = *(const LAS bf16x8*)(lds + G_SB(b, h) + boff + n * 2048 + k * 1024); } while (0)
#define G_MMA(ai, bj, At, Bt) do { __builtin_amdgcn_s_setprio(1); _Pragma("unroll") for (int m = 0; m < 4; ++m) _Pragma("unroll") for (int n = 0; n < 2; ++n) _Pragma("unroll") for (int k = 0; k < 2; ++k) \
    acc[ai][bj][m][n] = __builtin_amdgcn_mfma_f32_16x16x32_bf16(Bt[n][k], At[m][k], acc[ai][bj][m][n], 0, 0, 0); __builtin_amdgcn_s_setprio(0); } while (0)
#define WAIT_V(n) asm volatile("s_waitcnt vmcnt(" #n ")" ::: "memory")
#define WAIT_L(n) asm volatile("s_waitcnt lgkmcnt(" #n ")" ::: "memory")
#define BAR __builtin_amdgcn_s_barrier()
#define SCHED __builtin_amdgcn_sched_barrier(0)

enum { GK_IN_EVEN = 0, GK_IN_ODD, GK_UPQ, GK_UPKV, GK_OUT_EVEN, GK_OUT_ODD };
__device__ __forceinline__ void gemm_unit(LAS unsigned char* lds, unsigned char* ws, int kind_, int li_, int pm_, int pn_, bool dry = false, const float* x0 = nullptr, const float* meta0 = nullptr) {
    asm volatile("" : "+s"(ws));
    const int kind = __builtin_amdgcn_readfirstlane(kind_), li = __builtin_amdgcn_readfirstlane(li_), pm = __builtin_amdgcn_readfirstlane(pm_), pn = __builtin_amdgcn_readfirstlane(pn_);
    int tid = threadIdx.x; asm volatile("" : "+v"(tid));
    const int wid = __builtin_amdgcn_readfirstlane(tid >> 6), lane = tid & 63, wr = wid >> 2, wc = wid & 3, fr = lane & 15, fq = lane >> 4;
    const bf16_t* A; const bf16_t* Bt; int lda, ldb, K;
    {
        const bf16_t* proj = (const bf16_t*)(ws + OFF_PROJ);
        if (kind == GK_IN_EVEN)       { A = (const bf16_t*)(ws + OFF_HB); lda = DM; Bt = (const bf16_t*)(ws + OFF_WINE + li * SZ_WIN); ldb = DM; K = DM; }
        else if (kind == GK_IN_ODD)   { A = (const bf16_t*)(ws + OFF_HB); lda = DM; Bt = (const bf16_t*)(ws + OFF_WINO + li * SZ_WIN); ldb = DM; K = DM; }
        else if (kind == GK_UPQ)      { A = proj + 1536; lda = NIN; Bt = (const bf16_t*)(ws + OFF_WUQ + li * SZ_WUQ); ldb = 256; K = 256; }
        else if (kind == GK_UPKV)     { A = proj + 1792; lda = NIN; Bt = (const bf16_t*)(ws + OFF_WUKV + li * SZ_WUKV); ldb = 256; K = 256; }
        else if (kind == GK_OUT_EVEN) { A = proj + E_GATE; lda = NIN; Bt = (const bf16_t*)(ws + OFF_WOUTE + li * SZ_WOUT); ldb = DM; K = DM; }
        else                          { A = proj + O_GATE; lda = NIN; Bt = (const bf16_t*)(ws + OFF_WOUTO + li * SZ_WOUT); ldb = DM; K = DM; }
    }
    unsigned voffA, voffB;
    { int R, C; stage_rc(tid * 16, R, C); voffA = (unsigned)((R * lda + C) * 2); voffB = (unsigned)((R * ldb + C) * 2); }
    const size_t qstepA = (size_t)64 * lda * 2, qstepB = (size_t)64 * ldb * 2;
    const char* Ab = (const char*)(A + (size_t)pm * 256 * lda);
    const char* Bb = (const char*)(Bt + (size_t)pn * 256 * ldb);
    const size_t hstepA = (size_t)128 * lda * 2, hstepB = (size_t)128 * ldb * 2;
    const unsigned ldsw = (unsigned)wid * 1024u;
    const int aoff = lds_byte(wr * 64 + fr, fq * 8), boff = lds_byte(wc * 32 + fr, fq * 8);
    f32x4 acc[2][2][4][2];
#pragma unroll
    for (int a = 0; a < 2; ++a)
#pragma unroll
        for (int b = 0; b < 2; ++b)
#pragma unroll
            for (int m = 0; m < 4; ++m)
#pragma unroll
                for (int n = 0; n < 2; ++n) acc[a][b][m][n] = (f32x4){0.f, 0.f, 0.f, 0.f};
    bf16x8 At[4][2], B0[2][2], B1[2][2];
    const int nt = K / 64;
    WAIT_V(0);
    G_STB(0, 0, 0); G_STA(0, 0, 0); G_STB(0, 1, 0); G_STA(0, 1, 0);
    if (wr == 1) BAR;
    WAIT_V(4); BAR;
    G_STB(1, 0, 1); G_STA(1, 0, 1); G_STB(1, 1, 1);
    WAIT_V(6); BAR;
    for (int t = 0; t < nt - 2; t += 2) {
        G_LDB(B0, 0, 0); SCHED; G_LDA(At, 0, 0); G_STA(1, 1, t + 1);
        WAIT_L(8); BAR; WAIT_L(0); G_MMA(0, 0, At, B0); BAR; SCHED;
        G_LDB(B1, 0, 1); G_STB(0, 0, t + 2);
        BAR; WAIT_L(0); G_MMA(0, 1, At, B1); BAR;
        G_LDA(At, 0, 1); G_STA(0, 0, t + 2);
        BAR; WAIT_L(0); G_MMA(1, 0, At, B0); BAR; SCHED;
        G_STB(0, 1, t + 2);
        WAIT_V(6); BAR; G_MMA(1, 1, At, B1); BAR;
        G_LDB(B0, 1, 0); SCHED; G_LDA(At, 1, 0); G_STA(0, 1, t + 2);
        WAIT_L(8); BAR; WAIT_L(0); G_MMA(0, 0, At, B0); BAR; SCHED;
        G_LDB(B1, 1, 1); G_STB(1, 0, t + 3);
        BAR; WAIT_L(0); G_MMA(0, 1, At, B1); BAR;
        G_LDA(At, 1, 1); G_STA(1, 0, t + 3);
        BAR; WAIT_L(0); G_MMA(1, 0, At, B0); BAR; SCHED;
        G_STB(1, 1, t + 3);
        WAIT_V(6); BAR; G_MMA(1, 1, At, B1); BAR;
    }
    { G_LDB(B0, 0, 0); G_LDA(At, 0, 0); G_STA(1, 1, nt - 1);
      BAR; WAIT_L(0); G_MMA(0, 0, At, B0); BAR;
      G_LDB(B1, 0, 1); BAR; WAIT_L(0); G_MMA(0, 1, At, B1); BAR;
      G_LDA(At, 0, 1); WAIT_V(4); BAR; WAIT_L(0); G_MMA(1, 0, At, B0); G_MMA(1, 1, At, B1); BAR; }
    { G_LDB(B0, 1, 0); G_LDA(At, 1, 0); WAIT_V(2); BAR; WAIT_L(0); G_MMA(0, 0, At, B0); BAR;
      G_LDB(B1, 1, 1); WAIT_V(0); BAR; WAIT_L(0); G_MMA(0, 1, At, B1); BAR;
      G_LDA(At, 1, 1); BAR; WAIT_L(0); G_MMA(1, 0, At, B0); G_MMA(1, 1, At, B1); BAR; }
    if (wr == 0) BAR;
    asm volatile("" ::: "memory");
    int tid_e = threadIdx.x; asm volatile("" : "+v"(tid_e));
    const int e_wid = tid_e >> 6, e_lane = tid_e & 63; const int e_wr = e_wid >> 2, e_wc = e_wid & 3, e_fr = e_lane & 15, e_fq = e_lane >> 4;
    Epi ep; ep.dst = (bf16_t*)(ws + OFF_PROJ); ep.ldd = NIN; ep.aux = nullptr; ep.rope = (const float2*)(ws + OFF_ROPE); ep.fac = 1.f; ep.tr = TR_NONE;
    if (kind == GK_IN_EVEN) {
        if (pn < 2) { ep.tr = TR_SCALE; ep.fac = 0.125f; }
        else if (pn == 6 || pn == 7) { ep.tr = TR_SSQ; ep.aux = (float*)(ws + OFF_SSQ) + (size_t)(li * 2 + (pn - 6)) * T; }
        else if (pn >= 8 && pn < 12) ep.tr = TR_SILU;
        else if (pn == 12) ep.tr = TR_ROPEKR;
    } else if (kind == GK_IN_ODD) {
        if (pn < 2 || pn == 3 || pn == 4) { ep.tr = TR_SCALE; ep.fac = 0.125f * LOG2E; }
        else if (pn >= 9) ep.tr = TR_SILU;
    } else if (kind == GK_UPQ) {
        ep.tr = TR_UPQ; ep.fac = 0.10206207261596577f * LOG2E; ep.dst = (bf16_t*)(ws + OFF_QM); ep.ldd = 768; ep.aux = (float*)(ws + OFF_SSQ) + (size_t)(li * 2) * T;
    } else if (kind == GK_UPKV) {
        ep.tr = TR_UPKV; ep.fac = 1.f; ep.dst = (bf16_t*)(ws + OFF_HB); ep.ldd = 1024; ep.aux = (float*)(ws + OFF_SSQ) + (size_t)(li * 2 + 1) * T;
    } else { ep.tr = TR_OUT; ep.aux = (float*)(ws + OFF_H); }
    const int tr = ep.tr;
#pragma unroll
    for (int ai = 0; ai < 2; ++ai)
#pragma unroll
        for (int m = 0; m < 4; ++m) {
            const int row = pm * 256 + ai * 128 + e_wr * 64 + m * 16 + e_fr;
            float rs = ep.fac, ss = 0.f;
            if (tr == TR_UPQ || tr == TR_UPKV) rs = ep.fac / sqrtf(*(const GAS float*)(ep.aux + row) * (1.0f / 256.0f) + 1e-6f);
            const int pp = row % LPAD;
#pragma unroll
            for (int bj = 0; bj < 2; ++bj)
#pragma unroll
                for (int n = 0; n < 2; ++n) {
                    const int col = pn * 256 + bj * 128 + e_wc * 32 + n * 16 + 4 * e_fq;
                    f32x4 v = acc[ai][bj][m][n];
                    if (tr == TR_OUT) {
                        float* hp = ep.aux + (size_t)row * DM + col; f32x4 hv;
                        if (x0) {
                            hv = (f32x4){0.f, 0.f, 0.f, 0.f};
                            if (pp >= 64) hv = *(const GAS f32x4*)(x0 + ((size_t)((row / LPAD) * SEQ + pp - 64)) * DM + col);
                            else if (pp >= POFF) hv = *(const GAS f32x4*)(meta0 + (size_t)(pp - POFF) * DM + col);
                        } else hv = *(const GAS f32x4*)hp;
                        if (!dry) *(GAS f32x4*)hp = hv * DN_ALPHA + v;
                    } else {
                        if (tr == TR_SCALE || tr == TR_UPKV) v = v * rs;
                        else if (tr == TR_SILU) { v[0] = silu_f(v[0]); v[1] = silu_f(v[1]); v[2] = silu_f(v[2]); v[3] = silu_f(v[3]); }
                        else if (tr == TR_SSQ) ss += v[0] * v[0] + v[1] * v[1] + v[2] * v[2] + v[3] * v[3];
                        else if (tr == TR_ROPEKR) {
                            const int rc = col - E_KR;
                            if (rc < 32) { const f32x2 c0 = *(const GAS f32x2*)((const float*)ep.rope + 2 * (pp * 16 + (rc >> 1))), c1 = *(const GAS f32x2*)((const float*)ep.rope + 2 * (pp * 16 + (rc >> 1) + 1));
                                const float a0 = v[0] * c0.x - v[1] * c0.y, b0 = v[1] * c0.x + v[0] * c0.y, a1 = v[2] * c1.x - v[3] * c1.y, b1 = v[3] * c1.x + v[2] * c1.y;
                                v = (f32x4){a0, b0, a1, b1}; }
                        } else if (tr == TR_UPQ) {
                            v = v * rs; const int rc = (col % 96) - 64;
                            if (rc >= 0) { const f32x2 c0 = *(const GAS f32x2*)((const float*)ep.rope + 2 * (pp * 16 + (rc >> 1))), c1 = *(const GAS f32x2*)((const float*)ep.rope + 2 * (pp * 16 + (rc >> 1) + 1));
                                const float a0 = v[0] * c0.x - v[1] * c0.y, b0 = v[1] * c0.x + v[0] * c0.y, a1 = v[2] * c1.x - v[3] * c1.y, b1 = v[3] * c1.x + v[2] * c1.y;
                                v = (f32x4){a0, b0, a1, b1}; }
                        }
                        if (!(tr == TR_ROPEKR && col >= E_KR + 32)) store4bf(ep.dst + (size_t)row * ep.ldd + col, v);
                    }
                }
            if (tr == TR_SSQ) { ss += shx(ss, 16, e_lane); ss += shx(ss, 32, e_lane); if (e_fq == 0 && !dry) atomicAdd(ep.aux + row, ss); }
            SCHED;
        }
}

enum { M_SB = 0, M_MLA = 1, M_SWA = 2, M_FOX = 3 };
constexpr int ATT_FLAGS = 2 * (12288 + 8192);
constexpr int ATT_UTMP = ATT_FLAGS + 64;
constexpr int ATT_UOFF = ATT_UTMP + 544;
constexpr int ATT_CB = ATT_UOFF + 544 + 384;
#define MFMA32(a, b, c) __builtin_amdgcn_mfma_f32_32x32x16_bf16(a, b, c, 0, 0, 0)
__device__ __forceinline__ s16x4 vtr(const LAS unsigned char* p) { return __builtin_bit_cast(s16x4, __builtin_amdgcn_ds_read_tr16_b64_v4i16((LAS s16x4*)p)); }

template <int MODE>
__device__ __forceinline__ void attn_unit(const Params& P, LAS unsigned char* lds, int li, int b, int h, int qt, bool dry = false) {
    constexpr int DK = (MODE == M_MLA) ? 96 : 64, NKS = DK / 16, KBYTES = (DK / 8) * 1024, BUFB = KBYTES + 8192;
    int tid = threadIdx.x; asm volatile("" : "+v"(tid));
    const int lane = tid & 63, r32 = lane & 31, hi = lane >> 5;
    const int wid = __builtin_amdgcn_readfirstlane(tid >> 6);
    unsigned char* wsa = P.ws; asm volatile("" : "+s"(wsa));
    bf16_t* proj = (bf16_t*)(wsa + OFF_PROJ);
    const bf16_t* qm = (const bf16_t*)(wsa + OFF_QM);
    const bf16_t* kvb = (const bf16_t*)(wsa + OFF_HB);
    const size_t rowbase = (size_t)b * LPAD;
    const int q0 = qt * 256, qw0 = q0 + wid * 32, cw = qw0 >> 6, qi = qw0 + r32;
    const bool wave_on = qw0 < LPAD;
    const int jmax = (q0 + 255) / 64 < 64 ? (q0 + 255) / 64 : 64;
    int nband = jmax + 1, ntiles = jmax + 1;
    if (MODE == M_SWA) { const int jlo = (4 * qt - 2) > 1 ? (4 * qt - 2) : 1; nband = jmax - jlo + 1; ntiles = nband + 1; }
    const bf16_t *Qp, *Kp, *Vp, *K2p = nullptr; int ldq, ldk, ldv; bf16_t* Op;
    if (MODE == M_SB)       { Qp = proj + h * 64; ldq = NIN; Kp = proj + 512 + h * 64; ldk = NIN; Vp = proj + 1024 + h * 64; ldv = NIN; Op = proj + E_GATE + h * 64; }
    else if (MODE == M_MLA) { Qp = qm + h * 96; ldq = 768; Kp = kvb + h * 128; ldk = 1024; Vp = kvb + h * 128 + 64; ldv = 1024; K2p = proj + E_KR; Op = proj + E_GATE + 512 + h * 64; }
    else if (MODE == M_SWA) { Qp = proj + h * 64; ldq = NIN; Kp = proj + 512 + (h >> 2) * 64; ldk = NIN; Vp = proj + 640 + (h >> 2) * 64; ldv = NIN; Op = proj + O_GATE + h * 64; }
    else                    { Qp = proj + 768 + h * 64; ldq = NIN; Kp = proj + 1280 + h * 64; ldk = NIN; Vp = proj + 1792 + h * 64; ldv = NIN; Op = proj + O_GATE + 512 + h * 64; }

    LAS float* cb = (LAS float*)(lds + ATT_CB);
    if (MODE == M_FOX) {
        LAS float* utmp = (LAS float*)(lds + ATT_UTMP); LAS float* uo = (LAS float*)(lds + ATT_UOFF);
        const float* utot = (const float*)(wsa + OFF_UTOT) + (size_t)(b * 8 + h) * 256;
        const float* lcum = (const float*)(wsa + OFF_LCUM) + (size_t)(b * 8 + h) * LPAD;
        if (tid < NUNIT_SEQ) utmp[tid] = utot[tid];
        __syncthreads();
        if (tid < NUNIT_SEQ) { float a = 0.f; for (int i = 0; i < tid; ++i) a += utmp[i]; uo[tid] = a; }
        __syncthreads();
        const float base = uo[q0 >> 5];
        const int kend = (q0 + 256) < LPAD ? (q0 + 256) : LPAD;
        for (int s = tid; s < kend; s += 512) cb[s] = (lcum[s] + uo[s >> 5] - base) * LOG2E;
    }
    float slope2 = 0.f, sink2 = 0.f;
    if (MODE == M_SWA) { slope2 = exp2f(-(float)(h + 1)) * LOG2E; sink2 = P.sinks[li * 8 + h] * LOG2E; }

    bf16x8 qf[NKS];
#pragma unroll
    for (int ks = 0; ks < NKS; ++ks) {
        if (wave_on) qf[ks] = *(const GAS bf16x8*)(Qp + (rowbase + qi) * ldq + ks * 16 + hi * 8);
        else qf[ks] = (bf16x8){0, 0, 0, 0, 0, 0, 0, 0};
    }
    f32x16 o[2];
#pragma unroll
    for (int r = 0; r < 16; ++r) { o[0][r] = 0.f; o[1][r] = 0.f; }
    float mrow = NEGB, lrow = 0.f, carry = 0.f;
    bool wdone = !wave_on;

    bf16x8 kreg0, kreg1, vreg;
    kreg1 = (bf16x8){0, 0, 0, 0, 0, 0, 0, 0};
#define TILE_OF(it) ((MODE == M_SWA) ? ((it) < nband ? jmax - (it) : 0) : jmax - (it))
#define GLOAD(j) do { const size_t r_ = rowbase + (size_t)64 * (j); \
        kreg0 = *(const GAS bf16x8*)(Kp + (r_ + lane) * ldk + wid * 8); \
        if (MODE == M_MLA && wid < 4) kreg1 = *(const GAS bf16x8*)(K2p + (r_ + lane) * NIN + wid * 8); \
        vreg = *(const GAS bf16x8*)(Vp + (r_ + 16 * (wid & 3) + (lane >> 2)) * ldv + (wid >> 2) * 32 + (lane & 3) * 8); } while (0)
#define LWRITE(buf) do { LAS unsigned char* b_ = lds + (buf) * BUFB; \
        *(LAS bf16x8*)(b_ + wid * 1024 + lane * 16) = kreg0; \
        if (MODE == M_MLA && wid < 4) *(LAS bf16x8*)(b_ + (8 + wid) * 1024 + lane * 16) = kreg1; \
        *(LAS bf16x8*)(b_ + KBYTES + wid * 1024 + lane * 16) = vreg; } while (0)

    GLOAD(TILE_OF(0)); LWRITE(0);
    __syncthreads();
    const int vbase = KBYTES + (4 * hi + ((lane & 15) >> 2)) * 64 + ((lane >> 4) & 1) * 32 + (lane & 3) * 8;
    for (int it = 0; it < ntiles; ++it) {
        const int j = TILE_OF(it);
        if (it + 1 < ntiles) GLOAD(TILE_OF(it + 1));
        bool act = wave_on && !wdone && (j <= cw);
        if (MODE == M_SWA) act = act && (j == 0 || j >= cw - 2);
        if (act) {
            const LAS unsigned char* kb = lds + (it & 1) * BUFB;
            f32x16 s[2];
#pragma unroll
            for (int r = 0; r < 16; ++r) { s[0][r] = 0.f; s[1][r] = 0.f; }
#pragma unroll
            for (int ks = 0; ks < NKS; ++ks) {
                const bf16x8 k0 = *(const LAS bf16x8*)(kb + (2 * ks + hi) * 1024 + r32 * 16);
                const bf16x8 k1 = *(const LAS bf16x8*)(kb + (2 * ks + hi) * 1024 + (32 + r32) * 16);
                s[0] = MFMA32(k0, qf[ks], s[0]); s[1] = MFMA32(k1, qf[ks], s[1]);
            }
            const int key0 = 64 * j + 4 * hi;
            if (MODE == M_SB) {
                float tl[8], tp[8], ab[8];
                f32x16 lsv[2];
#pragma unroll
                for (int n = 0; n < 2; ++n)
#pragma unroll
                    for (int g = 0; g < 4; ++g) {
                        float tsum = 0.f;
#pragma unroll
                        for (int i = 0; i < 4; ++i) {
                            const int reg = 4 * g + i, key = key0 + 32 * n + 8 * g + i;
                            const bool valid = (key < qi) && (key >= POFF);
                            const float z = s[n][reg];
                            const float e = __expf(-fabsf(z));
                            const float sp = fmaxf(z, 0.f) + __logf(1.f + e);
                            const float l = valid ? -sp : 0.f;
                            lsv[n][reg] = l; tsum += l;
                            s[n][reg] = valid ? (z - sp) : NEGB;
                        }
                        tl[4 * n + g] = tsum;
                    }
#pragma unroll
                for (int c = 0; c < 8; ++c) tp[c] = shx(tl[c], 32, lane);
                float accs = 0.f;
#pragma unroll
                for (int c = 7; c >= 0; --c) { ab[c] = accs + (hi == 0 ? tp[c] : 0.f); accs += tl[c] + tp[c]; }
#pragma unroll
                for (int n = 0; n < 2; ++n)
#pragma unroll
                    for (int g = 0; g < 4; ++g) {
                        float a = carry + ab[4 * n + g];
#pragma unroll
                        for (int i = 3; i >= 0; --i) {
                            const int reg = 4 * g + i;
                            const float w = __expf(s[n][reg] + a);
                            a += lsv[n][reg];
                            s[n][reg] = w;
                        }
                    }
                carry += accs;
            } else {
                if (MODE == M_FOX) {
#pragma unroll
                    for (int n = 0; n < 2; ++n)
#pragma unroll
                        for (int g = 0; g < 4; ++g) { const f32x4 c4 = *(const LAS f32x4*)(cb + key0 + 32 * n + 8 * g);
#pragma unroll
                            for (int i = 0; i < 4; ++i) s[n][4 * g + i] -= c4[i]; }
                }
                if (MODE == M_SWA) {
#pragma unroll
                    for (int n = 0; n < 2; ++n)
#pragma unroll
                        for (int r = 0; r < 16; ++r) { const int key = key0 + 32 * n + 8 * (r >> 2) + (r & 3); s[n][r] -= slope2 * fabsf((float)(qi - key)); }
                }
                if (j == 0) {
#pragma unroll
                    for (int n = 0; n < 2; ++n)
#pragma unroll
                        for (int r = 0; r < 16; ++r) { const int key = key0 + 32 * n + 8 * (r >> 2) + (r & 3); if (key < POFF) s[n][r] = NEGB; }
                }
                if (MODE == M_FOX && j == cw) {
#pragma unroll
                    for (int n = 0; n < 2; ++n)
#pragma unroll
                        for (int r = 0; r < 16; ++r) { const int key = key0 + 32 * n + 8 * (r >> 2) + (r & 3); if (key > qi) s[n][r] = NEGB; }
                }
                float mx = s[0][0];
#pragma unroll
                for (int r = 1; r < 16; ++r) mx = fmaxf(mx, s[0][r]);
#pragma unroll
                for (int r = 0; r < 16; ++r) mx = fmaxf(mx, s[1][r]);
                mx = fmaxf(mx, shx(mx, 32, lane));
                const float mnew = fmaxf(mrow, mx);
                const float alpha = __builtin_amdgcn_exp2f(mrow - mnew);
                mrow = mnew;
                float psum = 0.f;
#pragma unroll
                for (int n = 0; n < 2; ++n)
#pragma unroll
                    for (int r = 0; r < 16; ++r) { const float pv = __builtin_amdgcn_exp2f(s[n][r] - mnew); s[n][r] = pv; psum += pv; }
                lrow = lrow * alpha + psum;
#pragma unroll
                for (int r = 0; r < 16; ++r) { o[0][r] *= alpha; o[1][r] *= alpha; }
            }
#pragma unroll
            for (int n = 0; n < 2; ++n)
#pragma unroll
                for (int sp = 0; sp < 2; ++sp) {
                    u32x4 pw; pw.x = cvtpk(s[n][8 * sp + 0], s[n][8 * sp + 1]); pw.y = cvtpk(s[n][8 * sp + 2], s[n][8 * sp + 3]);
                    pw.z = cvtpk(s[n][8 * sp + 4], s[n][8 * sp + 5]); pw.w = cvtpk(s[n][8 * sp + 6], s[n][8 * sp + 7]);
                    const bf16x8 pb = __builtin_bit_cast(bf16x8, pw);
#pragma unroll
                    for (int db = 0; db < 2; ++db) {
                        const LAS unsigned char* vp = kb + vbase + db * 4096 + (32 * n + 16 * sp) * 64;
                        const s16x4 vlo = vtr(vp), vhi = vtr(vp + 8 * 64);
                        const bf16x8 va = (bf16x8){vlo[0], vlo[1], vlo[2], vlo[3], vhi[0], vhi[1], vhi[2], vhi[3]};
                        o[db] = MFMA32(va, pb, o[db]);
                    }
                }
        }
        if (MODE == M_SB) {
            const bool dn = !wave_on || (__builtin_amdgcn_ballot_w64(carry < -120.f) == ~0ull);
            wdone = dn;
            if (lane == 0) ((LAS unsigned*)(lds + ATT_FLAGS))[(it & 1) * 8 + wid] = dn ? 1u : 0u;
        }
        if (it + 1 < ntiles) LWRITE((it + 1) & 1);
        __syncthreads();
        if (MODE == M_SB) {
            const LAS unsigned* fl = (const LAS unsigned*)(lds + ATT_FLAGS) + (it & 1) * 8;
            const unsigned all = fl[0] & fl[1] & fl[2] & fl[3] & fl[4] & fl[5] & fl[6] & fl[7];
            if (all) break;
        }
    }
    __syncthreads();
    if (wave_on) {
        float inv = 1.f;
        if (MODE != M_SB) { float lt = lrow + shx(lrow, 32, lane); if (MODE == M_SWA) lt += __builtin_amdgcn_exp2f(sink2 - mrow); inv = 1.f / lt; }
        bf16_t* orow = Op + (rowbase + qi) * NIN;
#pragma unroll
        for (int db = 0; db < 2; ++db)
#pragma unroll
            for (int g = 0; g < 4; ++g) {
                bf16_t* p = orow + 32 * db + 8 * g + 4 * hi;
                const u32x2 gw = *(const GAS u32x2*)p;
                const float g0 = __uint_as_float(gw.x << 16), g1 = __uint_as_float(gw.x & 0xffff0000u), g2 = __uint_as_float(gw.y << 16), g3 = __uint_as_float(gw.y & 0xffff0000u);
                f32x4 v = (f32x4){o[db][4 * g + 0] * inv * g0, o[db][4 * g + 1] * inv * g1, o[db][4 * g + 2] * inv * g2, o[db][4 * g + 3] * inv * g3};
                if (!dry) store4bf(p, v);
            }
    }
#undef TILE_OF
#undef GLOAD
#undef LWRITE
}

template <int MODE>
__device__ __forceinline__ void attn_unit_sm(const Params& P, LAS unsigned char* lds, int li, int b, int h, int qt, bool dry = false) {
    constexpr int DK = (MODE == M_MLA) ? 96 : 64, NKS = DK / 16, KBYTES = (DK / 8) * 1024;
    constexpr int KB0 = 0, VB0 = 2 * KBYTES;
    constexpr float THR = 8.0f;
    int tid = threadIdx.x; asm volatile("" : "+v"(tid));
    const int lane = tid & 63, r32 = lane & 31, hi = lane >> 5;
    const int wid = __builtin_amdgcn_readfirstlane(tid >> 6);
    unsigned char* wsa = P.ws; asm volatile("" : "+s"(wsa));
    bf16_t* proj = (bf16_t*)(wsa + OFF_PROJ);
    const bf16_t* qm = (const bf16_t*)(wsa + OFF_QM);
    const bf16_t* kvb = (const bf16_t*)(wsa + OFF_HB);
    const size_t rowbase = (size_t)b * LPAD;
    const int q0 = qt * 256, qw0 = q0 + wid * 32, cw = qw0 >> 6, qi = qw0 + r32;
    const bool wave_on = qw0 < LPAD;
    const int jmax = (q0 + 255) / 64 < 64 ? (q0 + 255) / 64 : 64;
    int nband = jmax + 1, ntiles = jmax + 1;
    if (MODE == M_SWA) { const int jlo = (4 * qt - 2) > 1 ? (4 * qt - 2) : 1; nband = jmax - jlo + 1; ntiles = nband + 1; }
    const bf16_t *Qp, *Kp, *Vp, *K2p = nullptr; int ldq, ldk, ldv; bf16_t* Op;
    if (MODE == M_MLA)      { Qp = qm + h * 96; ldq = 768; Kp = kvb + h * 128; ldk = 1024; Vp = kvb + h * 128 + 64; ldv = 1024; K2p = proj + E_KR; Op = proj + E_GATE + 512 + h * 64; }
    else if (MODE == M_SWA) { Qp = proj + h * 64; ldq = NIN; Kp = proj + 512 + (h >> 2) * 64; ldk = NIN; Vp = proj + 640 + (h >> 2) * 64; ldv = NIN; Op = proj + O_GATE + h * 64; }
    else                    { Qp = proj + 768 + h * 64; ldq = NIN; Kp = proj + 1280 + h * 64; ldk = NIN; Vp = proj + 1792 + h * 64; ldv = NIN; Op = proj + O_GATE + 512 + h * 64; }

    LAS float* cb = (LAS float*)(lds + ATT_CB);
    if (MODE == M_FOX) {
        LAS float* utmp = (LAS float*)(lds + ATT_UTMP); LAS float* uo = (LAS float*)(lds + ATT_UOFF);
        const float* utot = (const float*)(wsa + OFF_UTOT) + (size_t)(b * 8 + h) * 256;
        const float* lcum = (const float*)(wsa + OFF_LCUM) + (size_t)(b * 8 + h) * LPAD;
        if (tid < NUNIT_SEQ) utmp[tid] = utot[tid];
        __syncthreads();
        if (tid < NUNIT_SEQ) { float a = 0.f; for (int i = 0; i < tid; ++i) a += utmp[i]; uo[tid] = a; }
        __syncthreads();
        const float base = uo[q0 >> 5];
        const int kend = (q0 + 256) < LPAD ? (q0 + 256) : LPAD;
        for (int s = tid; s < kend; s += 512) cb[s] = (lcum[s] + uo[s >> 5] - base) * LOG2E;
    }
    float slope2 = 0.f, sink2 = 0.f;
    if (MODE == M_SWA) { slope2 = exp2f(-(float)(h + 1)) * LOG2E; sink2 = P.sinks[li * 8 + h] * LOG2E; }

    bf16x8 qf[NKS];
#pragma unroll
    for (int ks = 0; ks < NKS; ++ks) {
        if (wave_on) qf[ks] = *(const GAS bf16x8*)(Qp + (rowbase + qi) * ldq + ks * 16 + hi * 8);
        else qf[ks] = (bf16x8){0, 0, 0, 0, 0, 0, 0, 0};
    }
    f32x16 o[2];
#pragma unroll
    for (int r = 0; r < 16; ++r) { o[0][r] = 0.f; o[1][r] = 0.f; }
    float mrow = 0.f, lrow = 0.f;
    bool first = true;

    bf16x8 kreg0, kreg1, vreg;
    kreg1 = (bf16x8){0, 0, 0, 0, 0, 0, 0, 0};
#define TILE_OF(it) ((MODE == M_SWA) ? ((it) < nband ? jmax - (it) : 0) : jmax - (it))
#define ACTIVE(j) (wave_on && ((j) <= cw) && (MODE != M_SWA || (j) == 0 || (j) >= cw - 2))
#define GLOAD_K(j) do { const size_t r_ = rowbase + (size_t)64 * (j); \
        kreg0 = *(const GAS bf16x8*)(Kp + (r_ + lane) * ldk + wid * 8); \
        if (MODE == M_MLA && wid < 4) kreg1 = *(const GAS bf16x8*)(K2p + (r_ + lane) * NIN + wid * 8); } while (0)
#define GLOAD_V(j) do { const size_t r_ = rowbase + (size_t)64 * (j); \
        vreg = *(const GAS bf16x8*)(Vp + (r_ + 16 * (wid & 3) + (lane >> 2)) * ldv + (wid >> 2) * 32 + (lane & 3) * 8); } while (0)
#define LWRITE_K(buf) do { LAS unsigned char* b_ = lds + KB0 + (buf) * KBYTES; \
        *(LAS bf16x8*)(b_ + wid * 1024 + lane * 16) = kreg0; \
        if (MODE == M_MLA && wid < 4) *(LAS bf16x8*)(b_ + (8 + wid) * 1024 + lane * 16) = kreg1; } while (0)
#define LWRITE_V(buf) do { *(LAS bf16x8*)(lds + VB0 + (buf) * 8192 + wid * 1024 + lane * 16) = vreg; } while (0)

    const int vbase = VB0 + (4 * hi + ((lane & 15) >> 2)) * 64 + ((lane >> 4) & 1) * 32 + (lane & 3) * 8;
    auto form = [&](f32x16& a0, f32x16& a1, int j, int kbuf, bool masks) {
        const float nm = -mrow;
        const int key0 = 64 * j + 4 * hi;
#pragma unroll
        for (int g = 0; g < 4; ++g) {
            f32x4 c0 = (f32x4){nm, nm, nm, nm}, c1 = c0;
            if (MODE == M_FOX) { c0 = c0 - *(const LAS f32x4*)(cb + key0 + 8 * g); c1 = c1 - *(const LAS f32x4*)(cb + key0 + 32 + 8 * g); }
#pragma unroll
            for (int i = 0; i < 4; ++i) {
                const int k0i = key0 + 8 * g + i, k1i = k0i + 32;
                float v0 = c0[i], v1 = c1[i];
                if (MODE == M_SWA) { v0 -= slope2 * fabsf((float)(qi - k0i)); v1 -= slope2 * fabsf((float)(qi - k1i)); }
                a0[4 * g + i] = v0; a1[4 * g + i] = v1;
            }
        }
        if (masks) {
            if (j == 0) {
#pragma unroll
                for (int r = 0; r < 16; ++r) { const int key = key0 + 8 * (r >> 2) + (r & 3); if (key < POFF) a0[r] = NEGB; if (key + 32 < POFF) a1[r] = NEGB; }
            }
            if (MODE == M_FOX && j == cw) {
#pragma unroll
                for (int r = 0; r < 16; ++r) { const int key = key0 + 8 * (r >> 2) + (r & 3); if (key > qi) a0[r] = NEGB; if (key + 32 > qi) a1[r] = NEGB; }
            }
        }
        const LAS unsigned char* kb = lds + KB0 + kbuf * KBYTES + hi * 1024 + r32 * 16;
        bf16x8 kf[2 * NKS];
#pragma unroll
        for (int ks = 0; ks < NKS; ++ks) { kf[2 * ks] = *(const LAS bf16x8*)(kb + ks * 2048); kf[2 * ks + 1] = *(const LAS bf16x8*)(kb + ks * 2048 + 512); }
#pragma unroll
        for (int ks = 0; ks < NKS; ++ks) { a0 = MFMA32(kf[2 * ks], qf[ks], a0); a1 = MFMA32(kf[2 * ks + 1], qf[ks], a1); }
    };
    auto adjust = [&](f32x16& s0, f32x16& s1) {
        float a = fmaxf(fmaxf(s0[0], s0[1]), s1[0]), c = fmaxf(fmaxf(s0[2], s0[3]), s1[1]); a = fmaxf(fmaxf(a, s1[2]), s1[3]);
#pragma unroll
        for (int r = 4; r < 16; r += 4) { a = fmaxf(fmaxf(a, s0[r]), s0[r + 1]); c = fmaxf(fmaxf(c, s0[r + 2]), s0[r + 3]); a = fmaxf(fmaxf(a, s1[r]), s1[r + 1]); c = fmaxf(fmaxf(c, s1[r + 2]), s1[r + 3]); }
        float mx = fmaxf(a, c);
        { auto rr = __builtin_amdgcn_permlane32_swap(__float_as_uint(mx), __float_as_uint(mx), false, false); mx = fmaxf(__uint_as_float(rr[0]), __uint_as_float(rr[1])); }
        const bool need = first || (__builtin_amdgcn_ballot_w64(mx > THR) != 0ull);
        if (need) {
            const float delta = first ? mx : fmaxf(mx, 0.f);
#pragma unroll
            for (int r = 0; r < 16; ++r) { s0[r] -= delta; s1[r] -= delta; }
            if (!first) {
                const float alpha = __builtin_amdgcn_exp2f(-delta);
                lrow *= alpha;
#pragma unroll
                for (int r = 0; r < 16; ++r) { o[0][r] *= alpha; o[1][r] *= alpha; }
            }
            mrow += delta;
            first = false;
        }
    };
    auto exp_pv = [&](f32x16& s0, f32x16& s1, int vbuf) {
        float ps0 = 0.f, ps1 = 0.f;
#pragma unroll
        for (int r = 0; r < 16; ++r) { s0[r] = __builtin_amdgcn_exp2f(s0[r]); s1[r] = __builtin_amdgcn_exp2f(s1[r]); ps0 += s0[r]; ps1 += s1[r]; }
        lrow += ps0 + ps1;
        const LAS unsigned char* vb = lds + vbase + vbuf * 8192;
#pragma unroll
        for (int n = 0; n < 2; ++n)
#pragma unroll
            for (int sp = 0; sp < 2; ++sp) {
                const f32x16& sv = n ? s1 : s0;
                u32x4 pw; pw.x = cvtpk(sv[8 * sp + 0], sv[8 * sp + 1]); pw.y = cvtpk(sv[8 * sp + 2], sv[8 * sp + 3]);
                pw.z = cvtpk(sv[8 * sp + 4], sv[8 * sp + 5]); pw.w = cvtpk(sv[8 * sp + 6], sv[8 * sp + 7]);
                const bf16x8 pb = __builtin_bit_cast(bf16x8, pw);
#pragma unroll
                for (int db = 0; db < 2; ++db) {
                    const LAS unsigned char* vp = vb + db * 4096 + (32 * n + 16 * sp) * 64;
                    const s16x4 vlo = vtr(vp), vhi = vtr(vp + 8 * 64);
                    const bf16x8 va = (bf16x8){vlo[0], vlo[1], vlo[2], vlo[3], vhi[0], vhi[1], vhi[2], vhi[3]};
                    o[db] = MFMA32(va, pb, o[db]);
                }
            }
    };

    f32x16 sA0, sA1, sB0, sB1;
#pragma unroll
    for (int r = 0; r < 16; ++r) { sA0[r] = 0.f; sA1[r] = 0.f; sB0[r] = 0.f; sB1[r] = 0.f; }
    const int nbandit = (MODE == M_SWA) ? ntiles : (ntiles < 4 ? ntiles : 4);
    GLOAD_K(TILE_OF(0)); GLOAD_V(TILE_OF(0)); LWRITE_K(0); LWRITE_V(0);
    __syncthreads();
    for (int it = 0; it < nbandit; ++it) {
        const int j = TILE_OF(it);
        if (it + 1 < ntiles) { GLOAD_K(TILE_OF(it + 1)); GLOAD_V(TILE_OF(it + 1)); }
        if (ACTIVE(j)) { form(sA0, sA1, j, it & 1, true); adjust(sA0, sA1); exp_pv(sA0, sA1, it & 1); }
        if (it + 1 < ntiles) { LWRITE_K((it + 1) & 1); LWRITE_V((it + 1) & 1); }
        __syncthreads();
    }
    if (MODE != M_SWA && ntiles > 4) {
        { const int j5 = TILE_OF(5 < ntiles ? 5 : ntiles - 1); GLOAD_K(j5); }
        form(sA0, sA1, TILE_OF(4), 0, false);
        LWRITE_K(1);
        __syncthreads();
#define STEADY(it, c0, c1, n0, n1) do { \
            const int jn2_ = TILE_OF((it) + 2 < ntiles ? (it) + 2 : ntiles - 1), jn1_ = TILE_OF((it) + 1 < ntiles ? (it) + 1 : ntiles - 1); \
            GLOAD_K(jn2_); GLOAD_V(jn1_); \
            adjust(c0, c1); \
            form(n0, n1, jn1_, ((it) + 1) & 1, false); \
            exp_pv(c0, c1, (it) & 1); \
            LWRITE_K((it) & 1); LWRITE_V(((it) + 1) & 1); \
            __syncthreads(); } while (0)
        int it = 4;
        for (; it + 2 < ntiles; it += 2) { STEADY(it, sA0, sA1, sB0, sB1); STEADY(it + 1, sB0, sB1, sA0, sA1); }
        if (it + 1 < ntiles) {
            STEADY(it, sA0, sA1, sB0, sB1);
            { const int key0 = 4 * hi;
#pragma unroll
              for (int r = 0; r < 16; ++r) { const int key = key0 + 8 * (r >> 2) + (r & 3); if (key < POFF) sB0[r] = NEGB; if (key + 32 < POFF) sB1[r] = NEGB; } }
            adjust(sB0, sB1); exp_pv(sB0, sB1, (it + 1) & 1);
        } else {
            { const int key0 = 4 * hi;
#pragma unroll
              for (int r = 0; r < 16; ++r) { const int key = key0 + 8 * (r >> 2) + (r & 3); if (key < POFF) sA0[r] = NEGB; if (key + 32 < POFF) sA1[r] = NEGB; } }
            adjust(sA0, sA1); exp_pv(sA0, sA1, it & 1);
        }
        __syncthreads();
#undef STEADY
    }
    if (wave_on) {
        float lt = lrow;
        { auto rr = __builtin_amdgcn_permlane32_swap(__float_as_uint(lt), __float_as_uint(lt), false, false); lt = __uint_as_float(rr[0]) + __uint_as_float(rr[1]); }
        if (MODE == M_SWA) lt += __builtin_amdgcn_exp2f(sink2 - mrow);
        const float inv = lt > 0.f ? 1.f / lt : 0.f;
        bf16_t* orow = Op + (rowbase + qi) * NIN;
#pragma unroll
        for (int db = 0; db < 2; ++db)
#pragma unroll
            for (int g = 0; g < 4; ++g) {
                bf16_t* p = orow + 32 * db + 8 * g + 4 * hi;
                const u32x2 gw = *(const GAS u32x2*)p;
                const float g0 = __uint_as_float(gw.x << 16), g1 = __uint_as_float(gw.x & 0xffff0000u), g2 = __uint_as_float(gw.y << 16), g3 = __uint_as_float(gw.y & 0xffff0000u);
                f32x4 v = (f32x4){o[db][4 * g + 0] * inv * g0, o[db][4 * g + 1] * inv * g1, o[db][4 * g + 2] * inv * g2, o[db][4 * g + 3] * inv * g3};
                if (!dry) store4bf(p, v);
            }
    }
#undef TILE_OF
#undef ACTIVE
#undef GLOAD_K
#undef GLOAD_V
#undef LWRITE_K
#undef LWRITE_V
}

template <class CM>
__device__ __forceinline__ void convert_T(LAS unsigned char* lds, const float* src, int lds_src, bf16_t* dst, int K, int Nd, const float* kscale, CM cm) {
    LAS float* tile = (LAS float*)lds;
    const int tid = threadIdx.x, tk = K / 64, tn = Nd / 64;
    for (int t = blockIdx.x; t < tk * tn; t += gridDim.x) {
        const int k0 = (t % tk) * 64, n0 = (t / tk) * 64;
#pragma unroll
        for (int i = 0; i < 8; ++i) {
            const int kk = i * 8 + (tid >> 6), nn = tid & 63; const int sc = cm(n0 + nn);
            float v = sc >= 0 ? src[(size_t)(k0 + kk) * lds_src + sc] : 0.f;
            if (kscale) v *= kscale[k0 + kk];
            tile[kk * 65 + nn] = v;
        }
        __syncthreads();
        { const int nn = tid >> 3, kc = (tid & 7) * 8; u32x4 w;
          w.x = cvtpk(tile[(kc + 0) * 65 + nn], tile[(kc + 1) * 65 + nn]); w.y = cvtpk(tile[(kc + 2) * 65 + nn], tile[(kc + 3) * 65 + nn]);
          w.z = cvtpk(tile[(kc + 4) * 65 + nn], tile[(kc + 5) * 65 + nn]); w.w = cvtpk(tile[(kc + 6) * 65 + nn], tile[(kc + 7) * 65 + nn]);
          *(u32x4*)(dst + (size_t)(n0 + nn) * K + k0 + kc) = w; }
        __syncthreads();
    }
}
struct CmIdent { __device__ __forceinline__ int operator()(int n) const { return n; } };
struct CmEvenIn { __device__ __forceinline__ int operator()(int n) const { if (n < 2048) return n; if (n < 3072) return n + 32; if (n < 3104) { const int rc = n - 3072; return 2048 + (rc >> 1) + 16 * (rc & 1); } return -1; } };
struct CmOddIn { __device__ __forceinline__ int operator()(int n) const { return n < 2304 ? n : n + 8; } };
struct CmUq { __device__ __forceinline__ int operator()(int n) const { const int hh = n / 96, c = n % 96; if (c < 64) return n; const int rc = c - 64; return hh * 96 + 64 + (rc >> 1) + 16 * (rc & 1); } };

__device__ __forceinline__ void prep_phase(const Params& P, LAS unsigned char* lds) {
    unsigned char* ws = P.ws;
    for (int i = 0; i < 2; ++i) {
        convert_T(lds, P.w_in_even + (size_t)i * DM * SRC_EVEN_IN, SRC_EVEN_IN, (bf16_t*)(ws + OFF_WINE + i * SZ_WIN), DM, NIN, nullptr, CmEvenIn());
        convert_T(lds, P.w_in_odd + (size_t)i * DM * SRC_ODD_IN, SRC_ODD_IN, (bf16_t*)(ws + OFF_WINO + i * SZ_WIN), DM, NIN, nullptr, CmOddIn());
        convert_T(lds, P.w_out_even + (size_t)i * DM * DM, DM, (bf16_t*)(ws + OFF_WOUTE + i * SZ_WOUT), DM, DM, nullptr, CmIdent());
        convert_T(lds, P.w_out_odd + (size_t)i * DM * DM, DM, (bf16_t*)(ws + OFF_WOUTO + i * SZ_WOUT), DM, DM, nullptr, CmIdent());
        convert_T(lds, P.w_uq + (size_t)i * 256 * 768, 768, (bf16_t*)(ws + OFF_WUQ + i * SZ_WUQ), 256, 768, P.g_cq + i * 256, CmUq());
        convert_T(lds, P.w_ukv + (size_t)i * 256 * 1024, 1024, (bf16_t*)(ws + OFF_WUKV + i * SZ_WUKV), 256, 1024, P.g_ckv + i * 256, CmIdent());
    }
    const size_t gtid = (size_t)blockIdx.x * 512 + threadIdx.x, gn = (size_t)gridDim.x * 512;
    bf16_t* HB = (bf16_t*)(ws + OFF_HB);
#pragma unroll 4
    for (size_t idx = gtid; idx < (size_t)T * 256; idx += gn) {
        const int row = (int)(idx >> 8), c4 = (int)(idx & 255), b = row / LPAD, pp = row % LPAD;
        f32x4 v = (f32x4){0.f, 0.f, 0.f, 0.f};
        if (pp >= 64) v = __builtin_nontemporal_load((const f32x4*)(P.x + ((size_t)(b * SEQ + pp - 64)) * DM + c4 * 4));
        else if (pp >= POFF) v = *(const f32x4*)(P.meta + (size_t)(pp - POFF) * DM + c4 * 4);
        store4bf(HB + (size_t)row * DM + c4 * 4, v);
    }
    float2* rope = (float2*)(ws + OFF_ROPE);
    for (size_t idx = gtid; idx < (size_t)LPAD * 16; idx += gn) {
        const int pp = (int)(idx >> 4), i = (int)(idx & 15); const int pos = pp >= POFF ? pp - POFF : 0;
        const float inv = powf(10000.0f, -(float)i / 16.0f); const float ang = (float)pos * inv;
        float sn, cs; sincosf(ang, &sn, &cs); rope[idx] = make_float2(cs, sn);
    }
    float* ssq = (float*)(ws + OFF_SSQ);
    for (size_t idx = gtid; idx < (size_t)4 * T; idx += gn) ssq[idx] = 0.f;
}

__device__ __forceinline__ void ln_phase(const Params& P, LAS unsigned char* lds, int layer, bool fz, int fi, bool last, bool dry = false) {
    int tid = threadIdx.x; asm volatile("" : "+v"(tid));
    const int lane = tid & 63, wid = tid >> 6;
    unsigned char* ws = P.ws; asm volatile("" : "+s"(ws));
    float* H = (float*)(ws + OFF_H); bf16_t* HB = (bf16_t*)(ws + OFF_HB);
    LAS float* wfz = (LAS float*)lds;
    LAS float* lc = (LAS float*)(lds + 32768);
    LAS float* wt = (LAS float*)(lds + 32768 + 1024);
    if (fz) {
        const float* src = P.w_in_odd + (size_t)fi * DM * SRC_ODD_IN + 2304;
        for (int e = tid; e < 8192; e += 512) wfz[e] = src[(size_t)(e >> 3) * SRC_ODD_IN + (e & 7)];
        __syncthreads();
    }
    const float* gain = P.ln_gain + layer * DM; const float* bias = P.ln_bias + layer * DM;
    f32x4 gv[4], bv[4];
#pragma unroll
    for (int i = 0; i < 4; ++i) { gv[i] = *(const GAS f32x4*)(gain + 4 * lane + 256 * i); bv[i] = *(const GAS f32x4*)(bias + 4 * lane + 256 * i); }
    const int myhd = ((lane & 1) << 2) | (lane & 2) | ((lane >> 2) & 1);
    const float bfg = fz ? P.b_forget[fi * 8 + myhd] : 0.f;
    for (int unit = blockIdx.x; unit < T / 32; unit += gridDim.x) {
        const int row0 = unit * 32 + wid * 4;
        f32x4 v[4][4];
#pragma unroll
        for (int rr = 0; rr < 4; ++rr)
#pragma unroll
            for (int i = 0; i < 4; ++i) v[rr][i] = *(const GAS f32x4*)(H + (size_t)(row0 + rr) * DM + 4 * lane + 256 * i);
        float s[4], q[4];
#pragma unroll
        for (int rr = 0; rr < 4; ++rr) { s[rr] = 0.f;
#pragma unroll
            for (int i = 0; i < 4; ++i) s[rr] += (v[rr][i][0] + v[rr][i][1]) + (v[rr][i][2] + v[rr][i][3]); }
#pragma unroll
        for (int o = 1; o < 64; o <<= 1)
#pragma unroll
            for (int rr = 0; rr < 4; ++rr) s[rr] += shx(s[rr], o, lane);
#pragma unroll
        for (int rr = 0; rr < 4; ++rr) { const float mu = s[rr] * (1.0f / 1024.0f); q[rr] = 0.f;
#pragma unroll
            for (int i = 0; i < 4; ++i) { v[rr][i] = v[rr][i] - mu; q[rr] += (v[rr][i][0] * v[rr][i][0] + v[rr][i][1] * v[rr][i][1]) + (v[rr][i][2] * v[rr][i][2] + v[rr][i][3] * v[rr][i][3]); } }
#pragma unroll
        for (int o = 1; o < 64; o <<= 1)
#pragma unroll
            for (int rr = 0; rr < 4; ++rr) q[rr] += shx(q[rr], o, lane);
#pragma unroll
        for (int rr = 0; rr < 4; ++rr) {
            const float rstd = 1.0f / sqrtf(q[rr] * (1.0f / 1024.0f) + 1e-5f);
#pragma unroll
            for (int i = 0; i < 4; ++i) v[rr][i] = v[rr][i] * rstd * gv[i] + bv[i];
            const int row = row0 + rr, b = row / LPAD, pp = row % LPAD;
            if (dry) { if (v[rr][0][0] == 123.456f) H[0] = 0.f; }
            else if (last) {
                if (pp >= 64) { float* op = P.out + ((size_t)(b * SEQ + pp - 64)) * DM;
#pragma unroll
                    for (int i = 0; i < 4; ++i) *(GAS f32x4*)(op + 4 * lane + 256 * i) = v[rr][i]; }
            } else {
#pragma unroll
                for (int i = 0; i < 4; ++i) { *(GAS f32x4*)(H + (size_t)row * DM + 4 * lane + 256 * i) = v[rr][i]; store4bf(HB + (size_t)row * DM + 4 * lane + 256 * i, v[rr][i]); }
            }
        }
        if (fz) {
            float run = 0.f;
#pragma unroll
            for (int rr = 0; rr < 4; ++rr) {
                float d[8];
#pragma unroll
                for (int hd = 0; hd < 8; ++hd) d[hd] = 0.f;
#pragma unroll
                for (int i = 0; i < 4; ++i)
#pragma unroll
                    for (int e = 0; e < 4; ++e) {
                        const LAS float* wp = wfz + (4 * lane + 256 * i + e) * 8; const f32x4 w0 = *(const LAS f32x4*)wp, w1 = *(const LAS f32x4*)(wp + 4);
                        const float y = v[rr][i][e];
                        d[0] += y * w0[0]; d[1] += y * w0[1]; d[2] += y * w0[2]; d[3] += y * w0[3]; d[4] += y * w1[0]; d[5] += y * w1[1]; d[6] += y * w1[2]; d[7] += y * w1[3];
                    }
                float e4[4], f2[2], g1;
#pragma unroll
                for (int k = 0; k < 4; ++k) { const float mine = (lane & 1) ? d[4 + k] : d[k], send = (lane & 1) ? d[k] : d[4 + k]; e4[k] = mine + shx(send, 1, lane); }
#pragma unroll
                for (int k = 0; k < 2; ++k) { const float mine = (lane & 2) ? e4[2 + k] : e4[k], send = (lane & 2) ? e4[k] : e4[2 + k]; f2[k] = mine + shx(send, 2, lane); }
                { const float mine = (lane & 4) ? f2[1] : f2[0], send = (lane & 4) ? f2[0] : f2[1]; g1 = mine + shx(send, 4, lane); }
                g1 += shx(g1, 8, lane); g1 += shx(g1, 16, lane); g1 += shx(g1, 32, lane);
                const float xx = g1 + bfg;
                const float lf = fminf(xx, 0.f) - log1pf(expf(-fabsf(xx)));
                run += lf;
                if (lane < 8) lc[(wid * 4 + rr) * 8 + myhd] = run;
            }
            if (lane < 8) wt[wid * 8 + myhd] = run;
            __syncthreads();
            const int b = (unit * 32) / LPAD, pp0 = (unit * 32) % LPAD;
            if (tid < 256 && !dry) {
                const int r = tid >> 3, hd = tid & 7, w = r >> 2; float off = 0.f;
                for (int w2 = 0; w2 < w; ++w2) off += wt[w2 * 8 + hd];
                ((float*)(ws + OFF_LCUM))[(size_t)(b * 8 + hd) * LPAD + pp0 + r] = lc[r * 8 + hd] + off;
            }
            if (tid < 8 && !dry) { float tt = 0.f; for (int w2 = 0; w2 < 8; ++w2) tt += wt[w2 * 8 + tid]; ((float*)(ws + OFF_UTOT))[(size_t)(b * 8 + tid) * 256 + (pp0 >> 5)] = tt; }
            __syncthreads();
        }
    }
}

__global__ void __launch_bounds__(512) fwd_megakernel(Params P) {
    extern __shared__ __attribute__((aligned(16))) unsigned char lds_raw[];
    LAS unsigned char* lds = (LAS unsigned char*)lds_raw;
    cg::grid_group grid = cg::this_grid();
    unsigned char* ws = P.ws;
    const int G = gridDim.x, bid = blockIdx.x;
    bf16_t* proj = (bf16_t*)(ws + OFF_PROJ);
    const float2* rope = (const float2*)(ws + OFF_ROPE);

    volatile LAS unsigned* xst = (volatile LAS unsigned*)(lds + 131072);
    if (threadIdx.x == 0) { xst[0] = 0u; xst[1] = 0u; xst[2] = 0u; xst[3] = 0u; }
    __syncthreads();
    XcdBarrier xbar = xcd_barrier_post((unsigned*)(ws + OFF_BAR), xst);
    for (int rep = 0; rep < REP_PREP; ++rep) { prep_phase(P, lds); if (rep + 1 < REP_PREP) grid.sync(); }
    grid.sync();
#define GSYNC() xcd_barrier(xbar)

    for (int layer = 0; layer < 4; ++layer) {
        const int li = layer >> 1; const bool even = (layer & 1) == 0;
        for (int rep = 0; rep < REP_GEMM; ++rep) {
            TileOrder ord; ord.init(NMT, 13);
            for (int i = 0;; ++i) {
                int pm, pn; if (!ord.get(i * G + bid, pm, pn)) break;
                gemm_unit(lds, ws, even ? GK_IN_EVEN : GK_IN_ODD, li, pm, pn, rep + 1 < REP_GEMM);
            }
            if (rep + 1 < REP_GEMM) GSYNC();
        }
        GSYNC();
        if (even) {
            for (int rep = 0; rep < REP_GEMM; ++rep) {
            for (int u = bid; u < NMT * 7; u += G) {
                int kind, pm, pn;
                if (u < NMT * 3) { kind = GK_UPQ; pm = u / 3; pn = u % 3; } else { const int u2 = u - NMT * 3; kind = GK_UPKV; pm = u2 / 4; pn = u2 % 4; }
                gemm_unit(lds, ws, kind, li, pm, pn);
            }
            if (rep + 1 < REP_GEMM) GSYNC();
            }
            GSYNC();
        }
        for (int rep = 0; rep < REP_ATTN; ++rep) {
        const bool dry = rep + 1 < REP_ATTN;
        for (int r = 0; r * G < 2176; ++r) {
            const int s = r * G + ((r & 1) ? (G - 1 - bid) : bid);
            if (s >= 2176) continue;
            const bool heavy = s < 1088; const int idx = heavy ? s : s - 1088;
            const int qt = 16 - idx / 64, bh = idx % 64, b = bh >> 3, h = bh & 7;
            if (even) { if (heavy) attn_unit_sm<M_MLA>(P, lds, li, b, h, qt, dry); else attn_unit<M_SB>(P, lds, li, b, h, qt, dry); }
            else      { if (heavy) attn_unit_sm<M_FOX>(P, lds, li, b, h, qt, dry); else attn_unit_sm<M_SWA>(P, lds, li, b, h, qt, dry); }
        }
        GSYNC();
        }
        for (int rep = 0; rep < REP_GEMM; ++rep) {
            TileOrder ord; ord.init(NMT, 4);
            for (int i = 0;; ++i) { int pm, pn; if (!ord.get(i * G + bid, pm, pn)) break;
                gemm_unit(lds, ws, even ? GK_OUT_EVEN : GK_OUT_ODD, li, pm, pn, rep + 1 < REP_GEMM, layer == 0 ? P.x : nullptr, layer == 0 ? P.meta : nullptr);
            }
            GSYNC();
        }
        for (int rep = 0; rep < REP_LN; ++rep) {
            ln_phase(P, lds, layer,  even,  li,  layer == 3, rep + 1 < REP_LN);
            if (rep + 1 < REP_LN) GSYNC();
        }
        if (layer < 3) GSYNC();
    }
}

extern "C" void kernel_launch(void* const* d_in, const int* in_sizes, int n_in, void* d_out, int out_size, void* d_ws, size_t ws_size, hipStream_t stream) {
    constexpr size_t kDynLds = 131072 + 16;
    static int grid_blocks = 0;
    if (!grid_blocks) {
        int dev = 0, cus = 0, per_cu = 0;
        hipGetDevice(&dev);
        hipDeviceGetAttribute(&cus, hipDeviceAttributeMultiprocessorCount, dev);
        hipFuncSetAttribute((const void*)fwd_megakernel, hipFuncAttributeMaxDynamicSharedMemorySize, (int)kDynLds);
        hipOccupancyMaxActiveBlocksPerMultiprocessor(&per_cu, (const void*)fwd_megakernel, 512, kDynLds);
        if (per_cu < 1) per_cu = 1;
        if (per_cu > 1) per_cu = 1;
        grid_blocks = cus * per_cu;
        if (ws_size < WS_END) fprintf(stderr, "kernel_launch: workspace too small: %zu < %zu\n", ws_size, (size_t)WS_END);
    }
    Params p{};
    p.x = (const float*)d_in[0]; p.meta = (const float*)d_in[1]; p.w_in_even = (const float*)d_in[2]; p.g_cq = (const float*)d_in[3]; p.g_ckv = (const float*)d_in[4];
    p.w_uq = (const float*)d_in[5]; p.w_ukv = (const float*)d_in[6]; p.w_out_even = (const float*)d_in[7]; p.w_in_odd = (const float*)d_in[8]; p.b_forget = (const float*)d_in[9];
    p.sinks = (const float*)d_in[10]; p.w_out_odd = (const float*)d_in[11]; p.ln_gain = (const float*)d_in[12]; p.ln_bias = (const float*)d_in[13];
    p.out = (float*)d_out; p.ws = (unsigned char*)d_ws;
    (void)hipMemsetAsync((unsigned char*)d_ws + OFF_BAR, 0, SZ_BAR, stream);
    void* args[] = {&p};
    hipError_t e = hipLaunchCooperativeKernel((const void*)fwd_megakernel, dim3(grid_blocks), dim3(512), args, kDynLds, stream);
    if (e != hipSuccess) fprintf(stderr, "cooperative launch failed: %s (grid %d)\n", hipGetErrorString(e), grid_blocks);
}
```
